# Optimizing an MI355X kernel written in HIP

```python
import math
import jax, jax.numpy as jnp
from jax import lax
import numpy as np

D_MODEL = 1024
BATCH = 16
SEQ = 256
DEPTH = 2
DEC_BATCH = 8
DEC_SEQ = 1024
PAST_LEN = 256

GRID_W = 64
ROPE_BASE = 10000.0
S5_WIDTH = 512
S5_GROUP = 16
S5_GROUPS = S5_WIDTH // S5_GROUP
S5_STATE = 64
GLA_HEADS = 4
GLA_DK = 64
GLA_DV = 128
GLA_QK = GLA_HEADS * GLA_DK
GLA_V = GLA_HEADS * GLA_DV
GLA_RANK = 16
GLA_NORMALIZER = 16.0
GLA_CHUNK = 32
ATT_HEADS = 8
ATT_KV_HEADS = 2
HEAD_DIM = 64
Q_PER_KV = ATT_HEADS // ATT_KV_HEADS
ATT_Q = ATT_HEADS * HEAD_DIM
ATT_KV = ATT_KV_HEADS * HEAD_DIM
WINDOW = 128
ATT_BLOCK = 128
N_BRANCH = 3
BRANCH_W = 512
IN_SIZES = (S5_WIDTH, GLA_QK, GLA_QK, GLA_V, GLA_V, GLA_RANK, GLA_RANK, ATT_Q, ATT_KV, ATT_KV, N_BRANCH * D_MODEL)
D_IN = sum(IN_SIZES)
FFN_HIDDEN = -(-8 * D_MODEL // (3 * 256)) * 256
RMS_EPS = 1e-6

kernel_name = 'hybrid_diffusion_s5_gla_swa_prefix_step'


def rmsnorm(x, g):
    xf = x.astype(jnp.float32)
    y = xf * lax.rsqrt(jnp.mean(xf * xf, axis=-1, keepdims=True) + RMS_EPS)
    return (y * g.astype(jnp.float32)).astype(x.dtype)


def axial_rope(x):
    L = x.shape[1]
    rows = L // GRID_W
    row = jnp.repeat(jnp.arange(rows, dtype=jnp.float32), GRID_W)
    col = jnp.tile(jnp.arange(GRID_W, dtype=jnp.float32), rows)
    half = HEAD_DIM // 2
    quarter = half // 2
    inv = ROPE_BASE ** (-jnp.arange(quarter, dtype=jnp.float32) / quarter)

    def rot(xa, pos):
        ang = pos[:, None] * inv[None, :]
        cos = jnp.cos(ang)[None, :, None, :]
        sin = jnp.sin(ang)[None, :, None, :]
        x1, x2 = xa[..., :quarter], xa[..., quarter:]
        return jnp.concatenate([x1 * cos - x2 * sin, x1 * sin + x2 * cos], axis=-1)

    return jnp.concatenate([rot(x[..., :half], row), rot(x[..., half:], col)], axis=-1)


def s5_discretize(lam_re, lam_im, log_step, b_re, b_im):
    lam_re = lam_re.astype(jnp.float32)
    lam_im = lam_im.astype(jnp.float32)
    dt = jnp.exp(log_step.astype(jnp.float32))
    mag = jnp.exp(lam_re * dt)
    ar = mag * jnp.cos(lam_im * dt)
    ai = mag * jnp.sin(lam_im * dt)
    nr, ni = ar - 1.0, ai
    den = lam_re * lam_re + lam_im * lam_im
    fr = (nr * lam_re + ni * lam_im) / den
    fi = (ni * lam_re - nr * lam_im) / den
    b_re = b_re.astype(jnp.float32)
    b_im = b_im.astype(jnp.float32)
    br = fr[..., None] * b_re - fi[..., None] * b_im
    bi = fr[..., None] * b_im + fi[..., None] * b_re
    return ar, ai, br, bi


def s5_scan(u, ar, ai, br, bi, h0_re, h0_im):
    bu_re = jnp.einsum('blgs,gps->blgp', u, br)
    bu_im = jnp.einsum('blgs,gps->blgp', u, bi)
    bu_re = bu_re.at[:, 0].add(ar * h0_re - ai * h0_im)
    bu_im = bu_im.at[:, 0].add(ar * h0_im + ai * h0_re)
    a_re = jnp.broadcast_to(ar, bu_re.shape)
    a_im = jnp.broadcast_to(ai, bu_im.shape)

    def combine(e1, e2):
        a1r, a1i, b1r, b1i = e1
        a2r, a2i, b2r, b2i = e2
        return (a1r * a2r - a1i * a2i, a1r * a2i + a1i * a2r,
                a2r * b1r - a2i * b1i + b2r, a2r * b1i + a2i * b1r + b2i)

    _, _, hr, hi = lax.associative_scan(combine, (a_re, a_im, bu_re, bu_im), axis=1)
    return hr, hi


def s5_branch(u_flat, h0, lp, want_state):
    B_, L, _ = u_flat.shape
    u = u_flat.astype(jnp.float32).reshape(B_, L, S5_GROUPS, S5_GROUP)
    h0 = h0.astype(jnp.float32)
    y = u * lp['s5_d'].astype(jnp.float32).reshape(S5_GROUPS, S5_GROUP)
    finals = []
    for d in range(2):
        ud = u if d == 0 else u[:, ::-1]
        ar, ai, br, bi = s5_discretize(lp['s5_lam_re'][d], lp['s5_lam_im'][d], lp['s5_log_step'][d],
                                       lp['s5_b_re'][d], lp['s5_b_im'][d])
        hr, hi = s5_scan(ud, ar, ai, br, bi, h0[:, d, :, :, 0], h0[:, d, :, :, 1])
        yd = (jnp.einsum('blgp,gsp->blgs', hr, lp['s5_c_re'][d].astype(jnp.float32))
              - jnp.einsum('blgp,gsp->blgs', hi, lp['s5_c_im'][d].astype(jnp.float32)))
        y = y + (yd if d == 0 else yd[:, ::-1])
        if want_state:
            finals.append(jnp.stack([hr[:, -1], hi[:, -1]], axis=-1))
    y = jax.nn.gelu(y.reshape(B_, L, S5_WIDTH))
    a, g = jnp.split(y @ lp['w_glu'].astype(jnp.float32), 2, axis=-1)
    out = (a * jax.nn.sigmoid(g)).astype(u_flat.dtype)
    fin = jnp.stack(finals, axis=1) if want_state else None
    return out, fin


def gla_chunked(q, k, v, gk, s0):
    B_, L, H, _ = q.shape
    n = L // GLA_CHUNK

    def chunk(t):
        return t.reshape(B_, n, GLA_CHUNK, H, t.shape[-1]).transpose(1, 0, 3, 2, 4)

    qc, kc, vc, gc = chunk(q), chunk(k), chunk(v), chunk(gk)
    bcum = jnp.cumsum(gc, axis=3)
    mask = jnp.tril(jnp.ones((GLA_CHUNK, GLA_CHUNK), dtype=bool))
    diff = bcum[..., :, None, :] - bcum[..., None, :, :]
    decay = jnp.exp(jnp.where(mask[:, :, None], diff, -jnp.inf))
    att = jnp.einsum('nbhid,nbhjd,nbhijd->nbhij', qc, kc, decay)
    o_intra = jnp.einsum('nbhij,nbhjv->nbhiv', att, vc)
    blast = bcum[..., -1:, :]
    q_in = qc * jnp.exp(bcum)
    k_out = kc * jnp.exp(blast - bcum)
    d_last = jnp.exp(blast[..., 0, :])

    def step(s, inp):
        qi, ko, vi, dl = inp
        o = jnp.einsum('bhcd,bhdv->bhcv', qi, s)
        s = s * dl[..., None] + jnp.einsum('bhcd,bhcv->bhdv', ko, vi)
        return s, o

    s_fin, o_inter = lax.scan(step, s0, (q_in, k_out, vc, d_last))
    o = (o_intra + o_inter).transpose(1, 0, 3, 2, 4).reshape(B_, L, H, v.shape[-1])
    return o, s_fin


def gla_branch(q_b, k_b, v_b, g_b, lr_f, lr_b, s0, lp, want_state):
    B_, L, _ = q_b.shape
    q = q_b.astype(jnp.float32).reshape(B_, L, GLA_HEADS, GLA_DK) * (GLA_DK ** -0.5)
    k = k_b.astype(jnp.float32).reshape(B_, L, GLA_HEADS, GLA_DK)
    v = v_b.astype(jnp.float32).reshape(B_, L, GLA_HEADS, GLA_DV)
    s0 = s0.astype(jnp.float32)
    o = None
    finals = []
    for d, lr in enumerate((lr_f, lr_b)):
        gk = jax.nn.log_sigmoid(lr.astype(jnp.float32) @ lp['gla_w_gk'][d].astype(jnp.float32)
                                + lp['gla_b_gk'][d].astype(jnp.float32)) / GLA_NORMALIZER
        gk = gk.reshape(B_, L, GLA_HEADS, GLA_DK)
        if d == 0:
            od, sd = gla_chunked(q, k, v, gk, s0[:, 0])
        else:
            od, sd = gla_chunked(q[:, ::-1], k[:, ::-1], v[:, ::-1], gk[:, ::-1], s0[:, 1])
            od = od[:, ::-1]
        o = od if o is None else o + od
        if want_state:
            finals.append(sd)
    o = rmsnorm(o, lp['gla_norm_g']).reshape(B_, L, GLA_V) * jax.nn.silu(g_b.astype(jnp.float32))
    fin = jnp.stack(finals, axis=1) if want_state else None
    return o.astype(q_b.dtype), fin


def context_attention(q, k, v, sink):
    B_, L = q.shape[:2]
    nb = L // ATT_BLOCK
    scale = HEAD_DIM ** -0.5
    qb = q.reshape(B_, nb, ATT_BLOCK, ATT_KV_HEADS, Q_PER_KV, HEAD_DIM).transpose(1, 0, 2, 3, 4, 5)
    sk = sink.astype(jnp.float32).reshape(ATT_KV_HEADS, Q_PER_KV)[None, :, :, None, None]

    def block(qblk):
        s = jnp.einsum('bqkgd,bskd->bkgqs', qblk, k) * scale
        m = jnp.maximum(jnp.max(s, axis=-1, keepdims=True), sk)
        p = jnp.exp(s - m)
        den = jnp.sum(p, axis=-1, keepdims=True) + jnp.exp(sk - m)
        o = jnp.einsum('bkgqs,bskd->bqkgd', p / den, v)
        return o

    o = lax.map(block, qb)
    return o.transpose(1, 0, 2, 3, 4, 5).reshape(B_, L, ATT_Q)


def latent_attention(q, k, v, ck, cv, sink):
    B_, L = q.shape[:2]
    nb = L // ATT_BLOCK
    scale = HEAD_DIM ** -0.5
    qb = q.reshape(B_, nb, ATT_BLOCK, ATT_KV_HEADS, Q_PER_KV, HEAD_DIM)

    def band(t):
        tb = t.reshape(B_, nb, ATT_BLOCK, ATT_KV_HEADS, HEAD_DIM)
        pad = jnp.pad(tb, ((0, 0), (1, 1), (0, 0), (0, 0), (0, 0)))
        return jnp.concatenate([pad[:, :-2], pad[:, 1:-1], pad[:, 2:]], axis=2)

    kw, vw = band(k), band(v)
    qpos = jnp.arange(ATT_BLOCK)[:, None]
    kpos = jnp.arange(3 * ATT_BLOCK)[None, :] - ATT_BLOCK
    abs_k = jnp.arange(nb)[:, None, None] * ATT_BLOCK + kpos[None]
    valid = (jnp.abs(kpos - qpos)[None] <= WINDOW) & (abs_k >= 0) & (abs_k < L)
    s_w = jnp.einsum('bnqkgd,bnskd->bnkgqs', qb, kw) * scale
    s_w = jnp.where(valid[None, :, None, None], s_w, -jnp.inf)
    s_c = jnp.einsum('bnqkgd,bskd->bnkgqs', qb, ck) * scale
    sk = sink.astype(jnp.float32).reshape(ATT_KV_HEADS, Q_PER_KV)[None, None, :, :, None, None]
    m = jnp.maximum(jnp.maximum(jnp.max(s_w, axis=-1, keepdims=True), jnp.max(s_c, axis=-1, keepdims=True)), sk)
    p_w = jnp.exp(s_w - m)
    p_c = jnp.exp(s_c - m)
    inv = 1.0 / (jnp.sum(p_w, axis=-1, keepdims=True) + jnp.sum(p_c, axis=-1, keepdims=True) + jnp.exp(sk - m))
    o = (jnp.einsum('bnkgqs,bnskd->bnqkgd', p_w * inv, vw)
         + jnp.einsum('bnkgqs,bskd->bnqkgd', p_c * inv, cv))
    return o.reshape(B_, L, ATT_Q)


def token_mix(h, lp, ctx):
    B_, L, _ = h.shape
    is_ctx = ctx is None
    z = h @ lp['w_in']
    offs = [int(o) for o in np.cumsum(IN_SIZES)[:-1]]
    u_a, q_b, k_b, v_b, g_b, lr_f, lr_b, q_c, k_c, v_c, gate_logits = jnp.split(z, offs, axis=-1)
    if is_ctx:
        s5_h0 = jnp.zeros((B_, 2, S5_GROUPS, S5_STATE, 2), jnp.float32)
        gla_s0 = jnp.zeros((B_, 2, GLA_HEADS, GLA_DK, GLA_DV), jnp.float32)
    else:
        ck, cv, s5_h0, gla_s0 = ctx
    y_a, s5_fin = s5_branch(u_a, s5_h0, lp, is_ctx)
    y_b, gla_fin = gla_branch(q_b, k_b, v_b, g_b, lr_f, lr_b, gla_s0, lp, is_ctx)
    k_heads = k_c.reshape(B_, L, ATT_KV_HEADS, HEAD_DIM)
    v_heads = v_c.reshape(B_, L, ATT_KV_HEADS, HEAD_DIM)
    q = q_c.astype(jnp.float32).reshape(B_, L, ATT_HEADS, HEAD_DIM)
    k = k_heads.astype(jnp.float32)
    v = v_heads.astype(jnp.float32)
    if is_ctx:
        y_c = context_attention(q, k, v, lp['att_sink'])
        new_ctx = (k_heads, v_heads, s5_fin, gla_fin)
    else:
        y_c = latent_attention(axial_rope(q), axial_rope(k), v, ck.astype(jnp.float32),
                               cv.astype(jnp.float32), lp['att_sink'])
        new_ctx = None
    ys = jnp.stack([y_a, y_b, y_c.astype(h.dtype)], axis=2)
    proj = jnp.einsum('blnc,ncd->blnd', ys, lp['w_branch'])
    gates = jax.nn.sigmoid(gate_logits.reshape(B_, L, N_BRANCH, D_MODEL))
    merged = jnp.sum(gates * proj, axis=2)
    return merged @ lp['w_out'], new_ctx


def swiglu(h, w1, w2):
    a, b = jnp.split(h @ w1, 2, axis=-1)
    return (jax.nn.silu(a) * b) @ w2


def trunk_layer(x, mod, lp, ctx):
    sh1, sc1, g1, sh2, sc2, g2 = jnp.split(mod[:, None, :], 6, axis=-1)
    h = rmsnorm(x, lp['norm_g'][0]) * (1 + sc1) + sh1
    mixed, new_ctx = token_mix(h, lp, ctx)
    x = x + g1 * rmsnorm(mixed, lp['norm_g'][1])
    h = rmsnorm(x, lp['norm_g'][2]) * (1 + sc2) + sh2
    x = x + g2 * rmsnorm(swiglu(h, lp['w_ffn_in'], lp['w_ffn_out']), lp['norm_g'][3])
    return x, new_ctx


def setup_inputs(seed: int = 0) -> dict:
    key = jax.random.key(seed)
    k = jax.random.split(key, 32)
    f32 = jnp.float32

    def nrm(i, shape, scale=1.0):
        return jax.random.normal(k[i], shape, f32) * scale

    s5_shape = (DEPTH, 2, S5_GROUPS, S5_STATE)
    n_idx = jnp.arange(S5_STATE, dtype=f32)
    return {
        'x_prompt': nrm(0, (BATCH, SEQ, D_MODEL)),
        'x_sample': nrm(1, (DEC_BATCH, DEC_SEQ, D_MODEL)),
        'cache_k': nrm(2, (DEC_BATCH, DEPTH, PAST_LEN, ATT_KV_HEADS, HEAD_DIM)),
        'cache_v': nrm(3, (DEC_BATCH, DEPTH, PAST_LEN, ATT_KV_HEADS, HEAD_DIM)),
        'state_s5': nrm(4, (DEC_BATCH, DEPTH, 2, S5_GROUPS, S5_STATE, 2), 0.3),
        'state_gla': nrm(5, (DEC_BATCH, DEPTH, 2, GLA_HEADS, GLA_DK, GLA_DV), 0.5),
        'c': nrm(6, (DEC_BATCH, D_MODEL)),
        'c_ctx': nrm(7, (D_MODEL,)),
        'w_mod': nrm(8, (DEPTH, D_MODEL, 6 * D_MODEL), 0.5 * D_MODEL ** -0.5),
        'b_mod': nrm(9, (DEPTH, 6 * D_MODEL), 0.02),
        'norm_g': 1.0 + nrm(10, (DEPTH, 4, D_MODEL), 0.02),
        'w_in': nrm(11, (DEPTH, D_MODEL, D_IN), D_MODEL ** -0.5),
        's5_lam_re': -0.5 + nrm(12, s5_shape, 0.01),
        's5_lam_im': math.pi * n_idx + nrm(13, s5_shape, 0.01),
        's5_log_step': jax.random.uniform(k[14], s5_shape, f32, math.log(1e-3), math.log(1e-1)),
        's5_b_re': nrm(15, s5_shape + (S5_GROUP,), (2 * S5_GROUP) ** -0.5),
        's5_b_im': nrm(16, s5_shape + (S5_GROUP,), (2 * S5_GROUP) ** -0.5),
        's5_c_re': nrm(17, (DEPTH, 2, S5_GROUPS, S5_GROUP, S5_STATE), (2 * S5_STATE) ** -0.5),
        's5_c_im': nrm(18, (DEPTH, 2, S5_GROUPS, S5_GROUP, S5_STATE), (2 * S5_STATE) ** -0.5),
        's5_d': nrm(19, (DEPTH, S5_WIDTH)),
        'w_glu': nrm(20, (DEPTH, S5_WIDTH, 2 * S5_WIDTH), S5_WIDTH ** -0.5),
        'gla_w_gk': nrm(21, (DEPTH, 2, GLA_RANK, GLA_QK), GLA_RANK ** -0.5),
        'gla_b_gk': nrm(22, (DEPTH, 2, GLA_QK), 0.1),
        'gla_norm_g': 1.0 + nrm(23, (DEPTH, GLA_DV), 0.02),
        'att_sink': nrm(24, (DEPTH, ATT_HEADS), 0.5),
        'w_branch': nrm(25, (DEPTH, N_BRANCH, BRANCH_W, D_MODEL), BRANCH_W ** -0.5),
        'w_out': nrm(26, (DEPTH, D_MODEL, D_MODEL), D_MODEL ** -0.5),
        'w_ffn_in': nrm(27, (DEPTH, D_MODEL, 2 * FFN_HIDDEN), D_MODEL ** -0.5),
        'w_ffn_out': nrm(28, (DEPTH, FFN_HIDDEN, D_MODEL), FFN_HIDDEN ** -0.5),
    }


def reference(x_prompt, x_sample, cache_k, cache_v, state_s5, state_gla, c, c_ctx,
              w_mod, b_mod, norm_g, w_in, s5_lam_re, s5_lam_im, s5_log_step, s5_b_re, s5_b_im,
              s5_c_re, s5_c_im, s5_d, w_glu, gla_w_gk, gla_b_gk, gla_norm_g, att_sink,
              w_branch, w_out, w_ffn_in, w_ffn_out):
    cond_ctx = jax.nn.silu(c_ctx)[None, :]
    cond_lat = jax.nn.silu(c)
    xp, xs = x_prompt, x_sample
    new_k, new_v, new_s5, new_gla = [], [], [], []
    for i in range(DEPTH):
        lp = {
            'norm_g': norm_g[i], 'w_in': w_in[i],
            's5_lam_re': s5_lam_re[i], 's5_lam_im': s5_lam_im[i], 's5_log_step': s5_log_step[i],
            's5_b_re': s5_b_re[i], 's5_b_im': s5_b_im[i], 's5_c_re': s5_c_re[i], 's5_c_im': s5_c_im[i],
            's5_d': s5_d[i], 'w_glu': w_glu[i],
            'gla_w_gk': gla_w_gk[i], 'gla_b_gk': gla_b_gk[i], 'gla_norm_g': gla_norm_g[i],
            'att_sink': att_sink[i], 'w_branch': w_branch[i], 'w_out': w_out[i],
            'w_ffn_in': w_ffn_in[i], 'w_ffn_out': w_ffn_out[i],
        }
        xp, (k_i, v_i, s5_i, gla_i) = trunk_layer(xp, cond_ctx @ w_mod[i] + b_mod[i], lp, None)
        new_k.append(k_i)
        new_v.append(v_i)
        new_s5.append(s5_i)
        new_gla.append(gla_i)
        xs, _ = trunk_layer(xs, cond_lat @ w_mod[i] + b_mod[i], lp,
                            (cache_k[:, i], cache_v[:, i], state_s5[:, i], state_gla[:, i]))
    return (xp, xs, jnp.stack(new_k, axis=1), jnp.stack(new_v, axis=1),
            jnp.stack(new_s5, axis=1), jnp.stack(new_gla, axis=1))
```

```cpp
#include <hip/hip_runtime.h>
#include <cstdio>
#include <cstdint>

#ifndef MK_PER_PHASE
#define MK_PER_PHASE 1
#endif

namespace pg8 {
#define PG8_LAS __attribute__((address_space(3)))
typedef unsigned short bf16_t;
typedef short bf16x8 __attribute__((ext_vector_type(8)));
typedef float f32x4 __attribute__((ext_vector_type(4)));
typedef float f32x2 __attribute__((ext_vector_type(2)));
typedef unsigned u32x4 __attribute__((ext_vector_type(4)));
typedef unsigned u32x2 __attribute__((ext_vector_type(2)));
constexpr int BM = 256, BK = 64, HALF = 128, HTB = HALF * BK * 2  , STAGE_BYTES = 8 * HTB, NXCD = 8, WGM = 8;

__host__ __device__ __forceinline__ int lds_byte(int r, int c) { const int st = (r >> 4) * 2 + (c >> 5), rr = r & 15, cc = c & 31, ob = rr * 64 + cc * 2; return st * 1024 + (ob ^ (((ob >> 9) & 1) << 5)); }
__host__ __device__ __forceinline__ void stage_rc(int b, int& R, int& C) { const int st = b / 1024, sb = b % 1024, swz = sb ^ (((sb >> 9) & 1) << 5); R = (st >> 1) * 16 + swz / 64; C = (st & 1) * 32 + (swz % 64) / 2; }
__host__ __device__ __forceinline__ int perm32(int rho) { const int n = rho >> 4, i = rho & 15; return 8 * (i >> 2) + 4 * n + (i & 3); }

struct Unit { int pm, pn, sel; };
struct Gemm { const bf16_t* A; const bf16_t* Bt; int M, N, K; const bf16_t* A1; const bf16_t* A2; };

struct StaticOrder {
    int nM, nN, nwg, G, c;
    __host__ __device__ void init(int M, int N, int G_, int c_) { nM = M / BM; nN = N / BM; nwg = nM * nN; G = G_; c = c_; }
    __host__ __device__ bool next(int i, Unit& u) const {
        const long L = (long)i * G + c; if (L >= nwg) return false;
        int wgid = (int)L; { const int q = nwg / NXCD, r = nwg % NXCD, xcd = wgid % NXCD, off = wgid / NXCD; wgid = (xcd < r ? xcd * (q + 1) : r * (q + 1) + (xcd - r) * q) + off; }
        const int nig = WGM * nN, gid = wgid / nig, fm = gid * WGM, gsz = (nM - fm) < WGM ? (nM - fm) : WGM;
        u.pm = fm + ((wgid % nig) % gsz); u.pn = (wgid % nig) / gsz; u.sel = 0; return true;
    }
    __device__ __forceinline__ const char* a_base(const Gemm& g, const Unit& u, size_t tstep) const { return (const char*)g.A + (size_t)u.pm * tstep; }
    __device__ __forceinline__ const char* b_base(const Gemm& g, const Unit& u, size_t tstep) const { return (const char*)g.Bt + (size_t)u.pn * tstep; }
};
struct BranchOrder {
    StaticOrder so;
    __host__ __device__ void init(int M, int N, int G_, int c_) { so.init(M, N, G_, c_); }
    __host__ __device__ bool next(int i, Unit& u) const { if (i >= 3) return false; if (!so.next(0, u)) return false; u.sel = i; return true; }
    __device__ __forceinline__ const char* a_base(const Gemm& g, const Unit& u, size_t tstep) const { const bf16_t* a = u.sel == 0 ? g.A : (u.sel == 1 ? g.A1 : g.A2); return (const char*)a + (size_t)u.pm * tstep; }
    __device__ __forceinline__ const char* b_base(const Gemm& g, const Unit& u, size_t tstep) const { return (const char*)g.Bt + (size_t)(u.sel * so.nN + u.pn) * tstep; }
};

__device__ __forceinline__ unsigned cvt_pk_bf16(float lo, float hi) { unsigned r; asm volatile("v_cvt_pk_bf16_f32 %0, %1, %2" : "=v"(r) : "v"(lo), "v"(hi)); return r; }
__device__ __forceinline__ float bf_lo(unsigned w) { return __builtin_bit_cast(float, w << 16); }
__device__ __forceinline__ float bf_hi(unsigned w) { return __builtin_bit_cast(float, w & 0xffff0000u); }
__device__ __forceinline__ float sigmoidf_(float x) { return 1.0f / (1.0f + __expf(-x)); }


struct EpiWin {
    static constexpr bool PERM = false, AFTER_DRAIN = false;
    bf16_t* Z; bf16_t* G; float* outk; float* outv; const float* rope;
    __device__ __forceinline__ void operator()(const f32x4 (&acc)[2][2][4][2], const Unit& u, int wr, int wc, int fr, int fq) const {
        const bool lat = u.pm >= 16;
        int rowb = u.pm * BM + wr * 64 + fr; asm volatile("" : "+v"(rowb));
#pragma unroll
        for (int bj = 0; bj < 2; ++bj) {
            const int c32 = u.pn * BM + bj * HALF + wc * 32;
            if (c32 >= 3072) {
#pragma unroll
                for (int ai = 0; ai < 2; ++ai)
#pragma unroll
                    for (int m = 0; m < 4; ++m) { bf16_t* gp = G + (size_t)(rowb + ai * HALF + m * 16) * 3072 + (c32 - 3072) + 4 * fq;
#pragma unroll
                        for (int n = 0; n < 2; ++n) { const f32x4 v = acc[ai][bj][m][n]; u32x2 w; w.x = cvt_pk_bf16(sigmoidf_(v[0]), sigmoidf_(v[1])); w.y = cvt_pk_bf16(sigmoidf_(v[2]), sigmoidf_(v[3])); *(u32x2*)(gp + 16 * n) = w; } }
            } else if (c32 >= 2848) {
            } else if (lat && c32 >= 2048 && c32 < 2688) {
                const float sc = c32 < 2560 ? 0.125f : 1.0f;
#pragma unroll
                for (int ai = 0; ai < 2; ++ai)
#pragma unroll
                    for (int m = 0; m < 4; ++m) { const int row = rowb + ai * HALF + m * 16, t = (row - 4096) & 1023, pos = (c32 & 32) ? (t & 63) : (t >> 6);
                        const f32x4* rp = (const f32x4*)(rope + (pos * 16 + 4 * fq) * 2); const f32x4 r0 = rp[0], r1 = rp[1];
                        const f32x4 x1 = acc[ai][bj][m][0] * sc, x2 = acc[ai][bj][m][1] * sc;
                        const f32x4 cs = (f32x4){r0[0], r0[2], r1[0], r1[2]}, sn = (f32x4){r0[1], r0[3], r1[1], r1[3]};
                        const f32x4 o1 = x1 * cs - x2 * sn, o2 = x1 * sn + x2 * cs;
                        bf16_t* zp = Z + (size_t)row * 2848 + c32 + 4 * fq;
                        u32x2 w; w.x = cvt_pk_bf16(o1[0], o1[1]); w.y = cvt_pk_bf16(o1[2], o1[3]); *(u32x2*)zp = w;
                        w.x = cvt_pk_bf16(o2[0], o2[1]); w.y = cvt_pk_bf16(o2[2], o2[3]); *(u32x2*)(zp + 16) = w; }
            } else {
                const float sc = ((c32 >= 512 && c32 < 768) || (c32 >= 2048 && c32 < 2560)) ? 0.125f : 1.0f;
                const bool kv32 = (!lat) && c32 >= 2560 && c32 < 2816;
                float* ob = c32 < 2688 ? outk : outv; const int cc = (c32 < 2688 ? c32 - 2560 : c32 - 2688) + 4 * fq;
#pragma unroll
                for (int ai = 0; ai < 2; ++ai)
#pragma unroll
                    for (int m = 0; m < 4; ++m) { const int row = rowb + ai * HALF + m * 16; bf16_t* zp = Z + (size_t)row * 2848 + c32 + 4 * fq;
#pragma unroll
                        for (int n = 0; n < 2; ++n) { const f32x4 v = acc[ai][bj][m][n] * sc; u32x2 w; w.x = cvt_pk_bf16(v[0], v[1]); w.y = cvt_pk_bf16(v[2], v[3]); *(u32x2*)(zp + 16 * n) = w;
                            if (kv32) *(f32x4*)(ob + (size_t)u.pm * 65536 + (size_t)(row & 255) * 128 + cc + 16 * n) = v; } }
            }
        }
    }
};
template <int MODE> struct EpiGlu {
    static constexpr bool PERM = true, AFTER_DRAIN = false;
    bf16_t* O; int ldc;
    __device__ __forceinline__ void operator()(const f32x4 (&acc)[2][2][4][2], const Unit& u, int wr, int wc, int fr, int fq) const {
        int row0 = u.pm * BM + wr * 64 + fr; asm volatile("" : "+v"(row0)); const int col0 = u.pn * HALF + wc * 32 + 8 * fq;
#pragma unroll
        for (int ai = 0; ai < 2; ++ai)
#pragma unroll
            for (int m = 0; m < 4; ++m) { bf16_t* rowp = O + (size_t)(row0 + ai * HALF + m * 16) * ldc + col0;
                f32x4 v[2];
#pragma unroll
                for (int n = 0; n < 2; ++n) { const f32x4 a = acc[ai][0][m][n], b = acc[ai][1][m][n];
#pragma unroll
                    for (int j = 0; j < 4; ++j) v[n][j] = MODE == 0 ? a[j] * sigmoidf_(b[j]) : a[j] * sigmoidf_(a[j]) * b[j]; }
                u32x4 w; w.x = cvt_pk_bf16(v[0][0], v[0][1]); w.y = cvt_pk_bf16(v[0][2], v[0][3]); w.z = cvt_pk_bf16(v[1][0], v[1][1]); w.w = cvt_pk_bf16(v[1][2], v[1][3]);
                *(u32x4*)rowp = w; }
    }
};
struct EpiBranch {
    static constexpr bool PERM = false, AFTER_DRAIN = false;
    const bf16_t* G; float* MF; bf16_t* MB;
    __device__ __forceinline__ void operator()(const f32x4 (&acc)[2][2][4][2], const Unit& u, int wr, int wc, int fr, int fq) const {
        int row0 = u.pm * BM + wr * 64 + fr; asm volatile("" : "+v"(row0)); const int col0 = u.pn * BM + wc * 32 + 4 * fq, sel = u.sel;
#pragma unroll
        for (int ai = 0; ai < 2; ++ai)
#pragma unroll
            for (int m = 0; m < 4; ++m) { const size_t row = (size_t)(row0 + ai * HALF + m * 16);
#pragma unroll
                for (int bj = 0; bj < 2; ++bj)
#pragma unroll
                    for (int n = 0; n < 2; ++n) { const int col = col0 + bj * HALF + n * 16;
                        const u32x2 gw = *(const u32x2*)(G + row * 3072 + sel * 1024 + col);
                        f32x4 v = acc[ai][bj][m][n] * (f32x4){bf_lo(gw.x), bf_hi(gw.x), bf_lo(gw.y), bf_hi(gw.y)};
                        if (sel > 0) v += *(const f32x4*)(MF + row * 1024 + col);
                        if (sel < 2) *(f32x4*)(MF + row * 1024 + col) = v;
                        else { u32x2 w; w.x = cvt_pk_bf16(v[0], v[1]); w.y = cvt_pk_bf16(v[2], v[3]); *(u32x2*)(MB + row * 1024 + col) = w; } } }
    }
};
struct EpiF32 {
    static constexpr bool PERM = false, AFTER_DRAIN = false;
    float* C; int ldc;
    __device__ __forceinline__ void operator()(const f32x4 (&acc)[2][2][4][2], const Unit& u, int wr, int wc, int fr, int fq) const {
        int row0 = u.pm * BM + wr * 64 + fr; asm volatile("" : "+v"(row0)); const int col0 = u.pn * BM + wc * 32 + 4 * fq;
#pragma unroll
        for (int ai = 0; ai < 2; ++ai)
#pragma unroll
            for (int m = 0; m < 4; ++m) { float* rowp = C + (size_t)(row0 + ai * HALF + m * 16) * ldc + col0;
#pragma unroll
                for (int bj = 0; bj < 2; ++bj)
#pragma unroll
                    for (int n = 0; n < 2; ++n) *(f32x4*)(rowp + bj * HALF + n * 16) = acc[ai][bj][m][n]; }
    }
};

template <class Epi, class Sched, bool ALIGN_EPI>
__device__ __forceinline__ void gemm_phase(PG8_LAS unsigned char* lds, const Gemm g, const Sched& S, const Epi& E, const int tid) {
    const int wid = __builtin_amdgcn_readfirstlane(tid >> 6), lane = tid & 63, wr = wid >> 2, wc = wid & 3, fr = lane & 15, fq = lane >> 4;
    const int K = g.K, nt = K / BK;
    unsigned voffA[2], voffB[2];
#pragma unroll
    for (int i = 0; i < 2; ++i) { int R, C; stage_rc(tid * 16 + i * 8192, R, C); const int Rb = Epi::PERM ? ((R & ~31) + perm32(R & 31)) : R;
        voffA[i] = (unsigned)(R * K + C) * 2u; voffB[i] = (unsigned)(Rb * K + C) * 2u; }
    const size_t kstep = (size_t)(BK * 2);
    const size_t hstep = (size_t)HALF * K * 2;
    const size_t tstep = 2 * hstep;
    const unsigned ldsw = (unsigned)wid * 1024u;
    const int aoff = lds_byte(wr * 64 + fr, fq * 8), boff = lds_byte(wc * 32 + fr, fq * 8);
#define PG8_SA(b, h) (((b) * 2 + (h)) * HTB)
#define PG8_SB(b, h) ((4 + (b) * 2 + (h)) * HTB)
#define PG8_STAGE(bufoff, gbase, voff) do { _Pragma("unroll") for (int _i = 0; _i < 2; ++_i) \
        __builtin_amdgcn_global_load_lds((const unsigned*)((const char*)(gbase) + (voff)[_i]), (PG8_LAS unsigned*)(lds + (bufoff) + ldsw + _i * 8192), 16, 0, 0); } while (0)
#define PG8_LDA(dst, b, h) do { _Pragma("unroll") for (int m = 0; m < 4; ++m) _Pragma("unroll") for (int k = 0; k < 2; ++k) dst[m][k] = *(const PG8_LAS bf16x8*)(lds + PG8_SA(b, h) + aoff + m * 2048 + k * 1024); } while (0)
#define PG8_LDB(dst, b, h) do { _Pragma("unroll") for (int n = 0; n < 2; ++n) _Pragma("unroll") for (int k = 0; k < 2; ++k) dst[n][k] = *(const PG8_LAS bf16x8*)(lds + PG8_SB(b, h) + boff + n * 2048 + k * 1024); } while (0)
#define PG8_MMA(ai, bj, At, Bt) do { __builtin_amdgcn_s_setprio(1); _Pragma("unroll") for (int m = 0; m < 4; ++m) _Pragma("unroll") for (int n = 0; n < 2; ++n) _Pragma("unroll") for (int k = 0; k < 2; ++k) \
        acc[ai][bj][m][n] = __builtin_amdgcn_mfma_f32_16x16x32_bf16(Bt[n][k], At[m][k], acc[ai][bj][m][n], 0, 0, 0); __builtin_amdgcn_s_setprio(0); } while (0)
#define PG8_WAIT_V(n) asm volatile("s_waitcnt vmcnt(" #n ")" ::: "memory")
#define PG8_WAIT_L(n) asm volatile("s_waitcnt lgkmcnt(" #n ")" ::: "memory")
#define PG8_BAR __builtin_amdgcn_s_barrier()
#define PG8_SCHED __builtin_amdgcn_sched_barrier(0)
    Unit cur, nxt; int ui = 0;
    if (!S.next(0, cur)) return;
    f32x4 acc[2][2][4][2];
#pragma unroll
    for (int a = 0; a < 2; ++a)
#pragma unroll
        for (int b = 0; b < 2; ++b)
#pragma unroll
            for (int m = 0; m < 4; ++m)
#pragma unroll
                for (int n = 0; n < 2; ++n) acc[a][b][m][n] = (f32x4){0.f, 0.f, 0.f, 0.f};
    bf16x8 At[4][2], B0[2][2], B1[2][2];
    const char* cA = S.a_base(g, cur, tstep); const char* cB = S.b_base(g, cur, tstep);
    PG8_STAGE(PG8_SB(0, 0), cB, voffB); PG8_STAGE(PG8_SB(0, 1), cB + hstep, voffB); PG8_STAGE(PG8_SA(0, 0), cA, voffA); PG8_STAGE(PG8_SA(0, 1), cA + hstep, voffA);
    if (wr == 1) PG8_BAR;
    PG8_WAIT_V(2); PG8_BAR;
    PG8_STAGE(PG8_SB(1, 0), cB + kstep, voffB); PG8_STAGE(PG8_SA(1, 0), cA + kstep, voffA); PG8_STAGE(PG8_SB(1, 1), cB + hstep + kstep, voffB);
    PG8_WAIT_V(6); PG8_BAR;
    for (;;) {
        const bool has_next = S.next(ui + 1, nxt);
        const char* nA = has_next ? S.a_base(g, nxt, tstep) : cA; const char* nB = has_next ? S.b_base(g, nxt, tstep) : cB;
        for (int t = 0; t < nt; t += 2) {
            const bool last = (t == nt - 2);
            const char* a1 = cA + (size_t)(t + 1) * kstep;
            const char* a2 = last ? nA : cA + (size_t)(t + 2) * kstep; const char* b2 = last ? nB : cB + (size_t)(t + 2) * kstep;
            const char* a3 = a2 + kstep; const char* b3 = b2 + kstep;
            PG8_LDB(B0, 0, 0); PG8_LDB(B1, 0, 1); PG8_SCHED; PG8_LDA(At, 0, 0); PG8_STAGE(PG8_SA(1, 1), a1 + hstep, voffA);
            PG8_WAIT_V(8); PG8_WAIT_L(0); PG8_BAR; PG8_MMA(0, 0, At, B0); PG8_MMA(0, 1, At, B1); PG8_BAR; PG8_SCHED;
            PG8_LDA(At, 0, 1); PG8_STAGE(PG8_SB(0, 0), b2, voffB); PG8_STAGE(PG8_SB(0, 1), b2 + hstep, voffB); PG8_STAGE(PG8_SA(0, 0), a2, voffA);
            PG8_WAIT_V(8); PG8_WAIT_L(0); PG8_BAR; PG8_MMA(1, 0, At, B0); PG8_MMA(1, 1, At, B1); PG8_BAR; PG8_SCHED;
            PG8_LDB(B0, 1, 0); PG8_LDB(B1, 1, 1); PG8_SCHED; PG8_LDA(At, 1, 0); PG8_STAGE(PG8_SA(0, 1), a2 + hstep, voffA);
            PG8_WAIT_V(8); PG8_WAIT_L(0); PG8_BAR; PG8_MMA(0, 0, At, B0); PG8_MMA(0, 1, At, B1); PG8_BAR; PG8_SCHED;
            PG8_LDA(At, 1, 1); PG8_STAGE(PG8_SB(1, 0), b3, voffB); PG8_STAGE(PG8_SB(1, 1), b3 + hstep, voffB); PG8_STAGE(PG8_SA(1, 0), a3, voffA);
            PG8_WAIT_V(8); PG8_WAIT_L(0); PG8_BAR; PG8_MMA(1, 0, At, B0); PG8_MMA(1, 1, At, B1); PG8_BAR; PG8_SCHED;
        }
        if constexpr (ALIGN_EPI) { if (wr == 0) PG8_BAR; }
        E(acc, cur, wr, wc, fr, fq);
        if (!has_next) break;
#pragma unroll
        for (int a = 0; a < 2; ++a)
#pragma unroll
            for (int b = 0; b < 2; ++b)
#pragma unroll
                for (int m = 0; m < 4; ++m)
#pragma unroll
                    for (int n = 0; n < 2; ++n) acc[a][b][m][n] = (f32x4){0.f, 0.f, 0.f, 0.f};
        cur = nxt; cA = nA; cB = nB; ++ui;
        if constexpr (ALIGN_EPI) { if (wr == 1) PG8_BAR; }
    }
    PG8_WAIT_V(0);
    if constexpr (!ALIGN_EPI) { if (wr == 0) PG8_BAR; }
    PG8_BAR;
#undef PG8_SA
#undef PG8_SB
#undef PG8_STAGE
#undef PG8_LDA
#undef PG8_LDB
#undef PG8_MMA
#undef PG8_WAIT_V
#undef PG8_WAIT_L
#undef PG8_BAR
#undef PG8_SCHED
}
}

constexpr int NWAVES = 8;
constexpr int DM = 1024, M_CTX = 4096, M_TOK = 12288, L_CTX = 256, L_LAT = 1024;
constexpr int ZP = 2848, GP = 3072, NZ = 6144, D_IN = 5920, FFH = 2816, FF2 = 5632;
constexpr float RMS_EPS = 1e-6f;
constexpr size_t O_Y = 0, O_CK = 12582912, O_CV = 13631488, O_S5 = 14680064, O_GLA = 14942208, O_END = 17039360;
enum { I_XP = 0, I_XS, I_CK, I_CV, I_SS5, I_SGLA, I_C, I_CCTX, I_WMOD, I_BMOD, I_NORMG, I_WIN, I_LRE, I_LIM, I_LSTEP, I_BRE, I_BIM, I_CRE, I_CIM, I_S5D, I_WGLU, I_WGK, I_BGK, I_GNG, I_SINK, I_WBR, I_WOUT, I_W1, I_W2, N_IN };

constexpr size_t MiB = 1u << 20;
constexpr size_t WS_CTL = 0, CTL_ZERO_BYTES = 64 * 1024;
constexpr size_t WS_MOD = 64 * 1024;
constexpr size_t WS_ROPE = 512 * 1024;
constexpr size_t WS_CKV = 1 * MiB;
constexpr size_t WS_W = 3 * MiB;
constexpr size_t WS_XN = 38 * MiB;
constexpr size_t WS_Z = 62 * MiB;
constexpr size_t WS_G = 129 * MiB;
constexpr size_t WS_GS = 201 * MiB;
constexpr size_t WS_Y = 225 * MiB;
constexpr size_t WS_END = 249 * MiB;
constexpr size_t WO_IN = 0, WO_GLU = 6291456, WO_BR = 6815744, WO_OUT = 8388608, WO_W1 = 9437184, WO_W2 = 15204352, WO_END = 18087936;
static_assert(WS_W + WO_END * 2 <= WS_XN && WS_XN + (size_t)M_TOK * 1024 * 2 <= WS_Z && WS_Z + (size_t)M_TOK * ZP * 2 <= WS_G && WS_G + (size_t)M_TOK * GP * 2 <= WS_GS && WS_GS + (size_t)M_TOK * 1024 * 2 <= WS_Y && WS_Y + (size_t)M_TOK * 1024 * 2 <= WS_END, "d_ws map");
constexpr int CW_BAR = 1024;

constexpr int RING_OFF = 0, RING_BYTES = 131072;
constexpr int LDSCTL_OFF = RING_BYTES, MISC_OFF = LDSCTL_OFF + 320;
constexpr int LDS_BYTES = 147456;
static_assert(MISC_OFF + 128 <= LDS_BYTES, "LDS map");

#define GAS __attribute__((address_space(1)))
#define LAS __attribute__((address_space(3)))
typedef unsigned short bf16;
typedef unsigned v4u __attribute__((ext_vector_type(4)));
typedef unsigned v2u __attribute__((ext_vector_type(2)));
typedef float f32x4 __attribute__((ext_vector_type(4)));
#define LDS_WAIT() asm volatile("s_waitcnt lgkmcnt(0)" ::: "memory")
__device__ __forceinline__ unsigned f2bf(float f) { unsigned u = __builtin_bit_cast(unsigned, f); return (u + 0x7fffu + ((u >> 16) & 1u)) >> 16; }
__device__ __forceinline__ unsigned pk2(float lo, float hi) { return f2bf(lo) | (f2bf(hi) << 16); }
__device__ __forceinline__ float bf2f(bf16 b) { return __builtin_bit_cast(float, ((unsigned)b) << 16); }
__device__ __forceinline__ float bflo(unsigned w) { return __builtin_bit_cast(float, w << 16); }
__device__ __forceinline__ float bfhi(unsigned w) { return __builtin_bit_cast(float, w & 0xffff0000u); }

#define XB_TMO      128
#define XB_XCNT(j)  (256  + 64 * (j))
#define XB_XSUB(j)  (1280 + 64 * (j))
#define XB_XGEN(j)  (2304 + 64 * (j))
#define XB_TOP      3328
#define XB_TOPGEN   3392
#define XCD_BAR_WORDS 3456
#define XB_SPIN_CAP (1u << 22)

__device__ __forceinline__ unsigned xb_ld(unsigned* p)              { return __hip_atomic_load(p, __ATOMIC_RELAXED, __HIP_MEMORY_SCOPE_AGENT); }
__device__ __forceinline__ unsigned xb_add(unsigned* p, unsigned v) { return __hip_atomic_fetch_add(p, v, __ATOMIC_RELAXED, __HIP_MEMORY_SCOPE_AGENT); }
__device__ __forceinline__ unsigned xb_xcc_id() { return (unsigned)__builtin_amdgcn_s_getreg((3 << 11) | 20) & 0xFu; }
#define XB_SPIN(cond, bar) do { unsigned _sp = 0; while (cond) { __builtin_amdgcn_s_sleep(1); \
    if ((++_sp & 255u) == 0u) { if (xb_ld(&(bar)[XB_TMO])) break; if (_sp > XB_SPIN_CAP) { atomicAdd(&(bar)[XB_TMO], 1u); break; } } } } while (0)

struct XcdBarrier {
    unsigned* bar; unsigned x;
    volatile LAS unsigned* st;
};

__device__ __forceinline__ XcdBarrier xcd_barrier_post(unsigned* bar, volatile LAS unsigned* st) {
    XcdBarrier b; b.bar = bar; b.x = xb_xcc_id(); b.st = st;
    if (threadIdx.x == 0) (void)xb_add(&bar[XB_XCNT(b.x)], 1u);
    return b;
}
__device__ __forceinline__ void xcd_barrier_complete(unsigned* bar, unsigned x, unsigned& nloc, unsigned& nx) {
    const unsigned G = gridDim.x * gridDim.y * gridDim.z;
    unsigned sum, cnt, mine, sp = 0u;
    for (;;) {
        sum = 0u; cnt = 0u; mine = 0u;
#pragma unroll
        for (unsigned j = 0; j < 16; ++j) { const unsigned c = xb_ld(&bar[XB_XCNT(j)]); sum += c; cnt += (c > 0u) ? 1u : 0u; mine = (j == x) ? c : mine; }
        if (sum == G) break;
        __builtin_amdgcn_s_sleep(1);
        if ((++sp & 255u) == 0u) { if (xb_ld(&bar[XB_TMO])) break; if (sp > XB_SPIN_CAP) { atomicAdd(&bar[XB_TMO], 1u); break; } }
    }
    nloc = mine > 0u ? mine : 1u; nx = cnt > 0u ? cnt : 1u;
}

__device__ __forceinline__ void xcd_barrier(const XcdBarrier& b) {
    asm volatile("s_waitcnt vmcnt(0)" ::: "memory");
    __syncthreads();
    if (threadIdx.x == 0) {
        unsigned* bar = b.bar;
        __builtin_amdgcn_s_waitcnt(0);
        unsigned nloc = b.st[0], nx = b.st[1];
        if (nloc == 0u) { xcd_barrier_complete(bar, b.x, nloc, nx); b.st[0] = nloc; b.st[1] = nx; }
        const unsigned old = xb_add(&bar[XB_XSUB(b.x)], 1u);
        const unsigned gen = old / nloc;
        if (old + 1u == (gen + 1u) * nloc) {
            __builtin_amdgcn_fence(__ATOMIC_RELEASE, "agent");
            asm volatile("s_waitcnt vmcnt(0)" ::: "memory");
            const unsigned og = xb_add(&bar[XB_TOP], 1u);
            const unsigned tg = og / nx;
            if (og + 1u == (tg + 1u) * nx) xb_add(&bar[XB_TOPGEN], 1u);
            else XB_SPIN(xb_ld(&bar[XB_TOPGEN]) == tg, bar);
            __builtin_amdgcn_fence(__ATOMIC_ACQUIRE, "agent");
            xb_add(&bar[XB_XGEN(b.x)], 1u);
            asm volatile("s_waitcnt vmcnt(0)" ::: "memory");
        } else {
            XB_SPIN(xb_ld(&bar[XB_XGEN(b.x)]) == gen, bar);
            __builtin_amdgcn_fence(__ATOMIC_ACQUIRE, "agent");
            asm volatile("s_waitcnt vmcnt(0)" ::: "memory");
        }
    }
    __syncthreads();
}


struct Args { const float* in[N_IN]; float* out; unsigned char* ws; int ph_lo, ph_hi; };
static_assert(sizeof(Args) == (N_IN + 2) * 8 + 8, "Args has no padding");
typedef const float* cfptr_t;
typedef const __attribute__((address_space(4))) cfptr_t* kargs_t;
struct Frame {
    unsigned char* lds;
    int tid, lane, wave, G, bid;
    kargs_t in; float* out; unsigned char* ws;
};
__device__ __forceinline__ float wave_sum(float v) {
#pragma unroll
    for (int o = 1; o < 64; o <<= 1) v += __shfl_xor(v, o);
    return v;
}
__device__ __forceinline__ const float* xin_row(const Frame& F, int row) { return row < M_CTX ? F.in[I_XP] + (size_t)row * DM : F.in[I_XS] + (size_t)(row - M_CTX) * DM; }
__device__ __forceinline__ int path_of(int row) { return row < M_CTX ? 0 : 1 + ((row - M_CTX) >> 10); }

__device__ __forceinline__ int map_row(int mapk, int n0) {
    if (mapk == 0) return n0;
    if (mapk == 1) { if (n0 < 2048) return n0; if (n0 < 2080) return 2816 + (n0 - 2048); if (n0 < 2848) return 2048 + (n0 - 2080); return 3072 + (n0 - 2848); }
    const int half = mapk == 2 ? 512 : 2816;
    if (n0 < half) return (n0 / 128) * 256 + (n0 % 128);
    const int s = n0 - half; return (s / 128) * 256 + 128 + (s % 128);
}
__device__ __forceinline__ void p0_transpose_item(const float* W, int K, int N, bf16* WT, int mapk, float* scr, int item, int lane) {
    const int nblk = N / 32, kb = item / nblk, nb = item % nblk, k0 = 64 * kb, n0 = 32 * nb, d0 = map_row(mapk, n0);
#pragma unroll 8
    for (int i = 0; i < 32; ++i) { const int kk = 2 * i + (lane >> 5); scr[kk * 33 + (lane & 31)] = W[(size_t)(k0 + kk) * N + n0 + (lane & 31)]; }
    LDS_WAIT(); asm volatile("" ::: "memory");
    const int c = lane & 7;
#pragma unroll
    for (int j = 0; j < 4; ++j) { const int n = (lane >> 3) + 8 * j; const float* s = scr + (8 * c) * 33 + n;
        v4u o; o.x = pk2(s[0 * 33], s[1 * 33]); o.y = pk2(s[2 * 33], s[3 * 33]); o.z = pk2(s[4 * 33], s[5 * 33]); o.w = pk2(s[6 * 33], s[7 * 33]);
        *(v4u*)(WT + (size_t)(d0 + n) * K + k0 + 8 * c) = o; }
    LDS_WAIT(); asm volatile("" ::: "memory");
}
__device__ __forceinline__ void convert_weights(const Frame& F, int l) {
    float* scr = (float*)(F.lds + RING_OFF + F.wave * 16384);
    bf16* WT = (bf16*)(F.ws + WS_W);
    const int gw = F.bid * NWAVES + F.wave, NGW = F.G * NWAVES;
    constexpr int I0 = 16 * 185, I1 = 8 * 32, I2 = 3 * 8 * 32, I3 = 16 * 32, I4 = 16 * 176, I5 = 44 * 32;
    for (int it = gw; it < I0 + I1 + I2 + I3 + I4 + I5; it += NGW) {
        int r = it;
        if (r < I0) { p0_transpose_item(F.in[I_WIN] + (size_t)l * 1024 * D_IN, 1024, D_IN, WT + WO_IN, 1, scr, r, F.lane); continue; } r -= I0;
        if (r < I1) { p0_transpose_item(F.in[I_WGLU] + (size_t)l * 512 * 1024, 512, 1024, WT + WO_GLU, 2, scr, r, F.lane); continue; } r -= I1;
        if (r < I2) { const int n = r / 256; p0_transpose_item(F.in[I_WBR] + (size_t)(l * 3 + n) * 512 * 1024, 512, 1024, WT + WO_BR + (size_t)n * 1024 * 512, 0, scr, r % 256, F.lane); continue; } r -= I2;
        if (r < I3) { p0_transpose_item(F.in[I_WOUT] + (size_t)l * 1024 * 1024, 1024, 1024, WT + WO_OUT, 0, scr, r, F.lane); continue; } r -= I3;
        if (r < I4) { p0_transpose_item(F.in[I_W1] + (size_t)l * 1024 * FF2, 1024, FF2, WT + WO_W1, 3, scr, r, F.lane); continue; } r -= I4;
        p0_transpose_item(F.in[I_W2] + (size_t)l * FFH * 1024, FFH, 1024, WT + WO_W2, 0, scr, r, F.lane);
    }
}
__device__ __forceinline__ void mod_items(const Frame& F) {
    float* SC = (float*)(F.lds);
    float* RED = (float*)(F.lds + 40960);
    float* MOD = (float*)(F.ws + WS_MOD);
    if (F.bid >= 192) return;
    for (int i = F.tid; i < 9 * 1024; i += NWAVES * 64) { const float c = i < 1024 ? F.in[I_CCTX][i] : F.in[I_C][i - 1024]; SC[i] = c / (1.0f + __expf(-c)); }
    __syncthreads();
    const int item = F.bid, l = item / 96, col = (item % 96) * 64 + F.lane;
    const float* wm = F.in[I_WMOD] + ((size_t)l * 1024 + F.wave * 128) * 6144 + col;
    float acc[9];
#pragma unroll
    for (int r = 0; r < 9; ++r) acc[r] = 0.f;
#pragma unroll 8
    for (int kk = 0; kk < 128; ++kk) { const float wv = wm[(size_t)kk * 6144]; const int k = F.wave * 128 + kk;
#pragma unroll
        for (int r = 0; r < 9; ++r) acc[r] += SC[r * 1024 + k] * wv; }
#pragma unroll
    for (int r = 0; r < 9; ++r) RED[(F.wave * 9 + r) * 64 + F.lane] = acc[r];
    __syncthreads();
    for (int o = F.tid; o < 576; o += NWAVES * 64) { const int r = o >> 6, ln = o & 63; float s = F.in[I_BMOD][l * 6144 + (item % 96) * 64 + ln];
#pragma unroll
        for (int w = 0; w < 8; ++w) s += RED[(w * 9 + r) * 64 + ln];
        MOD[(size_t)(l * 9 + r) * 6144 + (item % 96) * 64 + ln] = s; }
    __syncthreads();
}
__device__ __forceinline__ void p0_prologue(const Frame& F) {
    mod_items(F);
    const int gt = F.bid * (NWAVES * 64) + F.tid, NGT = F.G * NWAVES * 64;
    if (gt < 1024) { const int pos = gt >> 4, q = gt & 15; const float inv = powf(10000.0f, -(float)q / 16.0f), ang = (float)pos * inv; float* rp = (float*)(F.ws + WS_ROPE); rp[gt * 2] = cosf(ang); rp[gt * 2 + 1] = sinf(ang); }
    { bf16* ck = (bf16*)(F.ws + WS_CKV); bf16* cv = ck + 524288;
      for (int i = gt; i < 524288; i += NGT) { const int c = i & 127, j = (i >> 7) & 255, b = (i >> 15) & 7, l = i >> 18; const size_t s = ((size_t)((b * 2 + l) * 256 + j)) * 128 + c;
          ck[i] = (bf16)f2bf(F.in[I_CK][s]); cv[i] = (bf16)f2bf(F.in[I_CV][s]); } }
    convert_weights(F, 0);
}

__device__ __forceinline__ void norm_phase(const Frame& F, int l, int mode) {
    const int gw = F.bid * NWAVES + F.wave, NGW = F.G * NWAVES;
    const float* MOD = (const float*)(F.ws + WS_MOD);
    const float* RAW = (const float*)(F.ws + WS_Z);
    bf16* XN = (bf16*)(F.ws + WS_XN);
    float* X = F.out + O_Y;
    for (int row = gw; row < M_TOK; row += NGW) {
        const int pb = path_of(row);
        const float* modl = MOD + (size_t)(l * 9 + pb) * 6144;
        const float* ng = F.in[I_NORMG] + l * 4096;
        const float* xs = (mode == 2 || l == 1) ? X + (size_t)row * DM : xin_row(F, row);
        f32x4 xv[4];
#pragma unroll
        for (int j = 0; j < 4; ++j) xv[j] = ((const f32x4*)xs)[F.lane + 64 * j];
        if (mode >= 1) {
            f32x4 rv[4]; float ss = 0.f;
#pragma unroll
            for (int j = 0; j < 4; ++j) { rv[j] = ((const f32x4*)(RAW + (size_t)row * DM))[F.lane + 64 * j]; ss += rv[j].x * rv[j].x + rv[j].y * rv[j].y + rv[j].z * rv[j].z + rv[j].w * rv[j].w; }
            const float rstd = 1.0f / sqrtf(wave_sum(ss) * (1.0f / DM) + RMS_EPS);
            const float* gate = modl + (mode == 1 ? 2048 : 5120); const float* nga = ng + (mode == 1 ? 1024 : 3072);
#pragma unroll
            for (int j = 0; j < 4; ++j) { const f32x4 gv = ((const f32x4*)gate)[F.lane + 64 * j], nv = ((const f32x4*)nga)[F.lane + 64 * j]; xv[j] = xv[j] + gv * (rv[j] * rstd * nv); ((f32x4*)(X + (size_t)row * DM))[F.lane + 64 * j] = xv[j]; }
        }
        if (mode == 2 && l == 1) continue;
        const int ln = mode == 2 ? l + 1 : l;
        const float* modn = MOD + (size_t)(ln * 9 + pb) * 6144;
        const float* ngb = F.in[I_NORMG] + ln * 4096 + (mode == 1 ? 2048 : 0);
        const float* sc = modn + (mode == 1 ? 4096 : 1024); const float* sh = modn + (mode == 1 ? 3072 : 0);
        float ss = 0.f;
#pragma unroll
        for (int j = 0; j < 4; ++j) ss += xv[j].x * xv[j].x + xv[j].y * xv[j].y + xv[j].z * xv[j].z + xv[j].w * xv[j].w;
        const float rstd = 1.0f / sqrtf(wave_sum(ss) * (1.0f / DM) + RMS_EPS);
#pragma unroll
        for (int j = 0; j < 4; ++j) { const f32x4 nv = ((const f32x4*)ngb)[F.lane + 64 * j], sv = ((const f32x4*)sc)[F.lane + 64 * j], hv = ((const f32x4*)sh)[F.lane + 64 * j];
            const f32x4 o = xv[j] * rstd * nv * (sv + 1.0f) + hv; v2u w; w.x = pk2(o.x, o.y); w.y = pk2(o.z, o.w); ((v2u*)(XN + (size_t)row * DM))[F.lane + 64 * j] = w; }
    }
}

__device__ __forceinline__ float gelu_tanh(float x) { const float u = 0.7978845608028654f * (x + 0.044715f * x * x * x); return 0.5f * x * (1.0f + tanhf(u)); }
__device__ __forceinline__ void s5_item(const Frame& F, int l, int item) {
    const int w = F.wave, lane = F.lane, pair = item * 4 + (w >> 1), d = w & 1;
    const bool lat = pair < 256; const int pp = lat ? pair : pair - 256, b = pp >> 5, g = pp & 31;
    const int L = lat ? L_LAT : L_CTX, row0 = lat ? M_CTX + b * L_LAT : b * L_CTX;
    const bf16* Z = (const bf16*)(F.ws + WS_Z); bf16* SS = (bf16*)(F.ws + WS_XN);
    {
        const int pidx = ((l * 2 + d) * 32 + g) * 64 + lane;
        const float lre = F.in[I_LRE][pidx], lim = F.in[I_LIM][pidx], dt = expf(F.in[I_LSTEP][pidx]);
        const float mag = expf(lre * dt); float sn, cs; sincosf(lim * dt, &sn, &cs);
        const float ar = mag * cs, ai = mag * sn, nr = ar - 1.0f, ni = ai, den = lre * lre + lim * lim;
        const float fr = (nr * lre + ni * lim) / den, fi = (ni * lre - nr * lim) / den;
        float Bre[16], Bim[16], Cre[16], Cim[16];
#pragma unroll
        for (int s = 0; s < 16; ++s) { const float br = F.in[I_BRE][(size_t)pidx * 16 + s], bi = F.in[I_BIM][(size_t)pidx * 16 + s]; Bre[s] = fr * br - fi * bi; Bim[s] = fr * bi + fi * br;
            const size_t ci = ((size_t)(((l * 2 + d) * 32 + g) * 16 + s)) * 64 + lane; Cre[s] = F.in[I_CRE][ci]; Cim[s] = F.in[I_CIM][ci]; }
        float hr = 0.f, hi = 0.f;
        if (lat) { const size_t si = ((size_t)((((b * 2 + l) * 2 + d) * 32 + g) * 64 + lane)) * 2; hr = F.in[I_SS5][si]; hi = F.in[I_SS5][si + 1]; }
        bf16* scr = SS + (size_t)d * M_TOK * 512;
        for (int tt = 0; tt < L; ++tt) {
            const int t = d ? L - 1 - tt : tt; const size_t row = (size_t)(row0 + t);
            const v4u* up = (const v4u*)(Z + row * ZP + g * 16); const v4u u0 = up[0], u1 = up[1];
            float u[16];
            u[0] = bflo(u0.x); u[1] = bfhi(u0.x); u[2] = bflo(u0.y); u[3] = bfhi(u0.y); u[4] = bflo(u0.z); u[5] = bfhi(u0.z); u[6] = bflo(u0.w); u[7] = bfhi(u0.w);
            u[8] = bflo(u1.x); u[9] = bfhi(u1.x); u[10] = bflo(u1.y); u[11] = bfhi(u1.y); u[12] = bflo(u1.z); u[13] = bfhi(u1.z); u[14] = bflo(u1.w); u[15] = bfhi(u1.w);
            float bur = 0.f, bui = 0.f;
#pragma unroll
            for (int s = 0; s < 16; ++s) { bur += Bre[s] * u[s]; bui += Bim[s] * u[s]; }
            const float nhr = ar * hr - ai * hi + bur, nhi = ar * hi + ai * hr + bui; hr = nhr; hi = nhi;
            float v[16];
#pragma unroll
            for (int s = 0; s < 16; ++s) v[s] = Cre[s] * hr - Cim[s] * hi;
#pragma unroll
            for (int j = 0; j < 8; ++j) { const bool hb = (lane & 32) != 0; const float keep = hb ? v[j + 8] : v[j], send = hb ? v[j] : v[j + 8]; v[j] = keep + __shfl_xor(send, 32); }
#pragma unroll
            for (int j = 0; j < 4; ++j) { const bool hb = (lane & 16) != 0; const float keep = hb ? v[j + 4] : v[j], send = hb ? v[j] : v[j + 4]; v[j] = keep + __shfl_xor(send, 16); }
#pragma unroll
            for (int j = 0; j < 2; ++j) { const bool hb = (lane & 8) != 0; const float keep = hb ? v[j + 2] : v[j], send = hb ? v[j] : v[j + 2]; v[j] = keep + __shfl_xor(send, 8); }
            { const bool hb = (lane & 4) != 0; const float keep = hb ? v[1] : v[0], send = hb ? v[0] : v[1]; v[0] = keep + __shfl_xor(send, 4); }
            v[0] += __shfl_xor(v[0], 2); v[0] += __shfl_xor(v[0], 1);
            if ((lane & 3) == 0) scr[row * 512 + g * 16 + (lane >> 2)] = (bf16)f2bf(v[0]);
        }
        if (!lat) { float* so = F.out + O_S5 + ((size_t)((((b * 2 + l) * 2 + d) * 32 + g) * 64 + lane)) * 2; so[0] = hr; so[1] = hi; }
    }
    __syncthreads();
    const float* Dp = F.in[I_S5D] + l * 512;
    for (int idx = F.tid; idx < 4 * L * 16; idx += NWAVES * 64) {
        const int pl = idx / (L * 16), rem = idx - pl * L * 16, t = rem >> 4, s = rem & 15;
        const int p2 = item * 4 + pl, pp2 = lat ? p2 : p2 - 256, b2 = pp2 >> 5, g2 = pp2 & 31;
        const size_t row = (size_t)((lat ? M_CTX + b2 * L_LAT : b2 * L_CTX) + t); const int col = g2 * 16 + s;
        const float y = bf2f(SS[row * 512 + col]) + bf2f(SS[(size_t)M_TOK * 512 + row * 512 + col]) + Dp[col] * bf2f(Z[row * ZP + col]);
        SS[row * 512 + col] = (bf16)f2bf(gelu_tanh(y));
    }
    __syncthreads();
}
__device__ __forceinline__ void gla_item(const Frame& F, int l, int item) {
    const bool lat = item < 32; const int ii = lat ? item : item - 32, b = ii >> 2, h = ii & 3;
    const int L = lat ? L_LAT : L_CTX, row0 = lat ? M_CTX + b * L_LAT : b * L_CTX;
    const int d = F.tid >> 8, ht = F.tid & 255, dv = ht & 127, kg = ht >> 7;
    const bf16* Z = (const bf16*)(F.ws + WS_Z); bf16* GS = (bf16*)(F.ws + WS_GS); bf16* YB = (bf16*)(F.ws + WS_Y);
    float* sm = (float*)(F.lds) + d * 1024;
    float S[32];
#pragma unroll
    for (int i = 0; i < 32; ++i) S[i] = lat ? F.in[I_SGLA][((size_t)((((b * 2 + l) * 2 + d) * 4 + h) * 64 + kg * 32 + i)) * 128 + dv] : 0.f;
    float wg[16], bg = 0.f;
#pragma unroll
    for (int r = 0; r < 16; ++r) wg[r] = 0.f;
    if (ht < 64) {
#pragma unroll
        for (int r = 0; r < 16; ++r) wg[r] = F.in[I_WGK][((size_t)((l * 2 + d) * 16 + r)) * 256 + h * 64 + ht];
        bg = F.in[I_BGK][(l * 2 + d) * 256 + h * 64 + ht];
    }
    for (int tt = 0; tt < L; ++tt) {
        const int t = d ? L - 1 - tt : tt; const size_t row = (size_t)(row0 + t); const bf16* zr = Z + row * ZP;
        if (ht < 64) {
            const v4u* lp = (const v4u*)(zr + 2816 + d * 16); const v4u a0 = lp[0], a1 = lp[1];
            float x = bg;
            x += wg[0] * bflo(a0.x) + wg[1] * bfhi(a0.x) + wg[2] * bflo(a0.y) + wg[3] * bfhi(a0.y) + wg[4] * bflo(a0.z) + wg[5] * bfhi(a0.z) + wg[6] * bflo(a0.w) + wg[7] * bfhi(a0.w);
            x += wg[8] * bflo(a1.x) + wg[9] * bfhi(a1.x) + wg[10] * bflo(a1.y) + wg[11] * bfhi(a1.y) + wg[12] * bflo(a1.z) + wg[13] * bfhi(a1.z) + wg[14] * bflo(a1.w) + wg[15] * bfhi(a1.w);
            const float ls = fminf(x, 0.f) - log1pf(expf(-fabsf(x)));
            sm[128 + ht] = expf(ls * 0.0625f); sm[ht] = bf2f(zr[512 + h * 64 + ht]); sm[64 + ht] = bf2f(zr[768 + h * 64 + ht]);
        } else if (ht < 192) sm[192 + ht - 64] = bf2f(zr[1024 + h * 128 + ht - 64]);
        __syncthreads();
        const float vv = sm[192 + dv]; float op = 0.f;
#pragma unroll
        for (int i = 0; i < 32; ++i) { const int dk = kg * 32 + i; S[i] = S[i] * sm[128 + dk] + sm[64 + dk] * vv; op += sm[dk] * S[i]; }
        sm[320 + kg * 128 + dv] = op;
        __syncthreads();
        if (kg == 0) GS[(size_t)d * M_TOK * 512 + row * 512 + h * 128 + dv] = (bf16)f2bf(sm[320 + dv] + sm[448 + dv]);
    }
    if (!lat) {
#pragma unroll
        for (int i = 0; i < 32; ++i) F.out[O_GLA + ((size_t)((((b * 2 + l) * 2 + d) * 4 + h) * 64 + kg * 32 + i)) * 128 + dv] = S[i];
    }
    __syncthreads();
    for (int t = F.wave; t < L; t += NWAVES) {
        const size_t row = (size_t)(row0 + t); const int c = h * 128 + 2 * F.lane;
        const unsigned a = *(const unsigned*)(GS + row * 512 + c), bb = *(const unsigned*)(GS + (size_t)M_TOK * 512 + row * 512 + c), gg = *(const unsigned*)(Z + row * ZP + 1536 + c);
        const float o0 = bflo(a) + bflo(bb), o1 = bfhi(a) + bfhi(bb);
        const float rstd = 1.0f / sqrtf(wave_sum(o0 * o0 + o1 * o1) * (1.0f / 128.0f) + RMS_EPS);
        const float g0 = bflo(gg), g1 = bfhi(gg);
        const float* gn = F.in[I_GNG] + l * 128 + 2 * F.lane;
        *(unsigned*)(YB + row * 512 + c) = pk2(o0 * rstd * gn[0] * (g0 / (1.0f + __expf(-g0))), o1 * rstd * gn[1] * (g1 / (1.0f + __expf(-g1))));
    }
    __syncthreads();
}
__device__ __forceinline__ void attn_key(float (&q)[64], float (&o)[64], float& m, float& ls, const bf16* kp, const bf16* vp, bool valid) {
    float s = 0.f;
#pragma unroll
    for (int c = 0; c < 8; ++c) { const v4u kw = ((const v4u*)kp)[c];
        s += q[8 * c] * bflo(kw.x) + q[8 * c + 1] * bfhi(kw.x) + q[8 * c + 2] * bflo(kw.y) + q[8 * c + 3] * bfhi(kw.y) + q[8 * c + 4] * bflo(kw.z) + q[8 * c + 5] * bfhi(kw.z) + q[8 * c + 6] * bflo(kw.w) + q[8 * c + 7] * bfhi(kw.w); }
    if (!valid) s = -INFINITY;
    const float mn = fmaxf(m, s), al = __expf(m - mn), p = __expf(s - mn);
    ls = ls * al + p; m = mn;
#pragma unroll
    for (int c = 0; c < 8; ++c) { const v4u vw = ((const v4u*)vp)[c];
        o[8 * c] = o[8 * c] * al + p * bflo(vw.x); o[8 * c + 1] = o[8 * c + 1] * al + p * bfhi(vw.x); o[8 * c + 2] = o[8 * c + 2] * al + p * bflo(vw.y); o[8 * c + 3] = o[8 * c + 3] * al + p * bfhi(vw.y);
        o[8 * c + 4] = o[8 * c + 4] * al + p * bflo(vw.z); o[8 * c + 5] = o[8 * c + 5] * al + p * bfhi(vw.z); o[8 * c + 6] = o[8 * c + 6] * al + p * bflo(vw.w); o[8 * c + 7] = o[8 * c + 7] * al + p * bfhi(vw.w); }
}
__device__ __forceinline__ void attn_item(const Frame& F, int l, int item) {
    const bool lat = item < 128; const int ii = lat ? item : item - 128;
    const int b = lat ? ii >> 4 : ii >> 2, qb = lat ? ii & 15 : ii & 3;
    const int row0 = lat ? M_CTX + b * L_LAT : b * L_CTX, h = F.wave, kvh = h >> 2, t = qb * 64 + F.lane;
    const bf16* Z = (const bf16*)(F.ws + WS_Z); bf16* YC = (bf16*)(F.ws + WS_Y) + (size_t)M_TOK * 512;
    float q[64], o[64];
    { const v4u* qp = (const v4u*)(Z + (size_t)(row0 + t) * ZP + 2048 + h * 64);
#pragma unroll
      for (int c = 0; c < 8; ++c) { const v4u w = qp[c]; q[8 * c] = bflo(w.x); q[8 * c + 1] = bfhi(w.x); q[8 * c + 2] = bflo(w.y); q[8 * c + 3] = bfhi(w.y); q[8 * c + 4] = bflo(w.z); q[8 * c + 5] = bfhi(w.z); q[8 * c + 6] = bflo(w.w); q[8 * c + 7] = bfhi(w.w); } }
#pragma unroll
    for (int c = 0; c < 64; ++c) o[c] = 0.f;
    float m = F.in[I_SINK][l * 8 + h], ls = 1.0f;
    if (lat) {
        const int j0 = qb * 64 - 128 < 0 ? 0 : qb * 64 - 128, j1 = qb * 64 + 191 > L_LAT - 1 ? L_LAT - 1 : qb * 64 + 191;
        for (int j = j0; j <= j1; ++j) { const bf16* zr = Z + (size_t)(row0 + j) * ZP; const int dj = t - j; attn_key(q, o, m, ls, zr + 2560 + kvh * 64, zr + 2688 + kvh * 64, dj <= 128 && dj >= -128); }
        const bf16* ck = (const bf16*)(F.ws + WS_CKV) + (size_t)((l * 8 + b) * 256) * 128; const bf16* cv = ck + 524288;
        for (int j = 0; j < 256; ++j) attn_key(q, o, m, ls, ck + (size_t)j * 128 + kvh * 64, cv + (size_t)j * 128 + kvh * 64, true);
    } else {
        for (int j = 0; j < L_CTX; ++j) { const bf16* zr = Z + (size_t)(row0 + j) * ZP; attn_key(q, o, m, ls, zr + 2560 + kvh * 64, zr + 2688 + kvh * 64, true); }
    }
    const float inv = 1.0f / ls;
    v4u* op = (v4u*)(YC + (size_t)(row0 + t) * 512 + h * 64);
#pragma unroll
    for (int c = 0; c < 8; ++c) { v4u w; w.x = pk2(o[8 * c] * inv, o[8 * c + 1] * inv); w.y = pk2(o[8 * c + 2] * inv, o[8 * c + 3] * inv); w.z = pk2(o[8 * c + 4] * inv, o[8 * c + 5] * inv); w.w = pk2(o[8 * c + 6] * inv, o[8 * c + 7] * inv); op[c] = w; }
}
__device__ __forceinline__ void mixer_phase(const Frame& F, int l) {
    for (int it = F.bid; it < 480; it += F.G) {
        if (it < 192) s5_item(F, l, it);
        else if (it < 288) gla_item(F, l, it - 192);
        else attn_item(F, l, it - 288);
    }
}

constexpr int N_PHASES = 20;
__global__ void __launch_bounds__(NWAVES * 64, 2) fwd_kernel(Args args) {
    extern __shared__ __attribute__((aligned(16))) unsigned char lds[];
    Frame F;
    F.lds = lds; F.tid = threadIdx.x; F.lane = F.tid & 63; F.wave = __builtin_amdgcn_readfirstlane(F.tid >> 6); F.G = gridDim.x; F.bid = blockIdx.x;
    F.in = (kargs_t)__builtin_amdgcn_kernarg_segment_ptr();
    F.out = (float*)F.in[N_IN]; F.ws = (unsigned char*)F.in[N_IN + 1];
    LAS unsigned char* llds = (LAS unsigned char*)lds;
    for (int u = F.tid; u < (LDS_BYTES - LDSCTL_OFF) / 4; u += NWAVES * 64) ((LAS unsigned*)(llds + LDSCTL_OFF))[u] = 0u;
    __syncthreads();
    XcdBarrier bar; bar.bar = (unsigned*)(F.ws + WS_CTL) + CW_BAR; bar.x = 0; bar.st = nullptr;
    const int ph_lo = args.ph_lo, ph_hi = args.ph_hi;
    if (ph_hi - ph_lo > 1) bar = xcd_barrier_post((unsigned*)(F.ws + WS_CTL) + CW_BAR, (volatile LAS unsigned*)(llds + MISC_OFF) + 8);
    for (int ph = ph_lo; ph < ph_hi; ++ph) {
        { kargs_t kp = (kargs_t)__builtin_amdgcn_kernarg_segment_ptr(); asm volatile("" : "+s"(kp)); F.in = kp; F.out = (float*)kp[N_IN]; F.ws = (unsigned char*)kp[N_IN + 1]; }
        { int tid = threadIdx.x; asm volatile("" : "+v"(tid)); int bid = blockIdx.x; asm volatile("" : "+s"(bid));
          F.tid = tid; F.lane = tid & 63; F.wave = __builtin_amdgcn_readfirstlane(tid >> 6); F.bid = bid; }
        unsigned char* ws = F.ws;
        bf16* WT = (bf16*)(ws + WS_W);
        if (ph == 0) p0_prologue(F);
        else if (ph == 1) norm_phase(F, 0, 0);
        else {
            const int l = (ph - 2) / 9, s = (ph - 2) % 9;
            if (s == 0) {
                pg8::Gemm g{(const bf16*)(ws + WS_XN), WT + WO_IN, M_TOK, NZ, 1024, nullptr, nullptr}; pg8::StaticOrder S; S.init(M_TOK, NZ, F.G, F.bid);
                pg8::EpiWin E{(bf16*)(ws + WS_Z), (bf16*)(ws + WS_G), F.out + O_CK + l * 32768, F.out + O_CV + l * 32768, (const float*)(ws + WS_ROPE)};
                pg8::gemm_phase<pg8::EpiWin, pg8::StaticOrder, true>(llds + RING_OFF, g, S, E, F.tid);
            } else if (s == 1) {
                mixer_phase(F, l);
            } else if (s == 2) {
                pg8::Gemm g{(const bf16*)(ws + WS_XN), WT + WO_GLU, M_TOK, 1024, 512, nullptr, nullptr}; pg8::StaticOrder S; S.init(M_TOK, 1024, F.G, F.bid);
                pg8::EpiGlu<0> E{(bf16*)(ws + WS_XN) + (size_t)M_TOK * 512, 512};
                pg8::gemm_phase<pg8::EpiGlu<0>, pg8::StaticOrder, true>(llds + RING_OFF, g, S, E, F.tid);
            } else if (s == 3) {
                pg8::Gemm g{(const bf16*)(ws + WS_XN) + (size_t)M_TOK * 512, WT + WO_BR, M_TOK, 1024, 512, (const bf16*)(ws + WS_Y), (const bf16*)(ws + WS_Y) + (size_t)M_TOK * 512};
                pg8::BranchOrder S; S.init(M_TOK, 1024, F.G, F.bid);
                pg8::EpiBranch E{(const bf16*)(ws + WS_G), (float*)(ws + WS_Z), (bf16*)(ws + WS_GS)};
                pg8::gemm_phase<pg8::EpiBranch, pg8::BranchOrder, true>(llds + RING_OFF, g, S, E, F.tid);
            } else if (s == 4) {
                pg8::Gemm g{(const bf16*)(ws + WS_GS), WT + WO_OUT, M_TOK, 1024, 1024, nullptr, nullptr}; pg8::StaticOrder S; S.init(M_TOK, 1024, F.G, F.bid);
                pg8::EpiF32 E{(float*)(ws + WS_Z), 1024};
                pg8::gemm_phase<pg8::EpiF32, pg8::StaticOrder, true>(llds + RING_OFF, g, S, E, F.tid);
            } else if (s == 5) {
                norm_phase(F, l, 1);
            } else if (s == 6) {
                pg8::Gemm g{(const bf16*)(ws + WS_XN), WT + WO_W1, M_TOK, FF2, 1024, nullptr, nullptr}; pg8::StaticOrder S; S.init(M_TOK, FF2, F.G, F.bid);
                pg8::EpiGlu<1> E{(bf16*)(ws + WS_G), FFH};
                pg8::gemm_phase<pg8::EpiGlu<1>, pg8::StaticOrder, true>(llds + RING_OFF, g, S, E, F.tid);
            } else if (s == 7) {
                pg8::Gemm g{(const bf16*)(ws + WS_G), WT + WO_W2, M_TOK, 1024, FFH, nullptr, nullptr}; pg8::StaticOrder S; S.init(M_TOK, 1024, F.G, F.bid);
                pg8::EpiF32 E{(float*)(ws + WS_Z), 1024};
                pg8::gemm_phase<pg8::EpiF32, pg8::StaticOrder, true>(llds + RING_OFF, g, S, E, F.tid);
            } else {
                norm_phase(F, l, 2);
                if (l == 0) convert_weights(F, 1);
            }
        }
        if (ph + 1 < ph_hi) xcd_barrier(bar);
    }
}

extern "C" void kernel_launch(void* const* d_in, const int* in_sizes, int n_in, void* d_out, int out_size, void* d_ws, size_t ws_size, hipStream_t stream) {
    static int grid = 0;
    if (grid == 0) {
        if (n_in != N_IN || out_size != (int)O_END || ws_size < WS_END) fprintf(stderr, "kernel_launch: unexpected shapes: n_in %d out %d ws %zu\n", n_in, out_size, ws_size);
        int dev = 0, cus = 0, per_cu = 0;
        if (hipGetDevice(&dev) != hipSuccess || hipDeviceGetAttribute(&cus, hipDeviceAttributeMultiprocessorCount, dev) != hipSuccess || cus <= 0) cus = 256;
        if (hipFuncSetAttribute((const void*)fwd_kernel, hipFuncAttributeMaxDynamicSharedMemorySize, LDS_BYTES) != hipSuccess) fprintf(stderr, "kernel_launch: hipFuncSetAttribute failed\n");
        if (hipOccupancyMaxActiveBlocksPerMultiprocessor(&per_cu, (const void*)fwd_kernel, NWAVES * 64, LDS_BYTES) != hipSuccess || per_cu < 1) fprintf(stderr, "kernel_launch: occupancy query reports %d workgroups per CU\n", per_cu);
        (void)hipGetLastError();
        grid = cus;
    }
    (void)hipMemsetAsync((char*)d_ws + WS_CTL, 0, CTL_ZERO_BYTES, stream);
    Args a{};
    for (int i = 0; i < N_IN; ++i) a.in[i] = (const float*)d_in[i];
    a.out = (float*)d_out; a.ws = (unsigned char*)d_ws;
#if MK_PER_PHASE
    for (int ph = 0; ph < N_PHASES; ++ph) { a.ph_lo = ph; a.ph_hi = ph + 1; hipLaunchKernelGGL(fwd_kernel, dim3(grid), dim3(NWAVES * 64), LDS_BYTES, stream, a); }
#else
    a.ph_lo = 0; a.ph_hi = N_PHASES;
    hipLaunchKernelGGL(fwd_kernel, dim3(grid), dim3(NWAVES * 64), LDS_BYTES, stream, a);
#endif
}
```

```cpp
#include <hip/hip_runtime.h>
#include <cstdio>
#include <cstdint>

#ifndef MK_PER_PHASE
#define MK_PER_PHASE 0
#endif

namespace pg8 {
#define PG8_LAS __attribute__((address_space(3)))
typedef unsigned short bf16_t;
typedef short bf16x8 __attribute__((ext_vector_type(8)));
typedef float f32x4 __attribute__((ext_vector_type(4)));
typedef float f32x2 __attribute__((ext_vector_type(2)));
typedef unsigned u32x4 __attribute__((ext_vector_type(4)));
typedef unsigned u32x2 __attribute__((ext_vector_type(2)));
constexpr int BM = 256, BK = 64, HALF = 128, HTB = HALF * BK * 2  , STAGE_BYTES = 8 * HTB, NXCD = 8, WGM = 8;

__host__ __device__ __forceinline__ int lds_byte(int r, int c) { const int st = (r >> 4) * 2 + (c >> 5), rr = r & 15, cc = c & 31, ob = rr * 64 + cc * 2; return st * 1024 + (ob ^ (((ob >> 9) & 1) << 5)); }
__host__ __device__ __forceinline__ void stage_rc(int b, int& R, int& C) { const int st = b / 1024, sb = b % 1024, swz = sb ^ (((sb >> 9) & 1) << 5); R = (st >> 1) * 16 + swz / 64; C = (st & 1) * 32 + (swz % 64) / 2; }
__host__ __device__ __forceinline__ int perm32(int rho) { const int n = rho >> 4, i = rho & 15; return 8 * (i >> 2) + 4 * n + (i & 3); }

struct Unit { int pm, pn, sel; };
struct Gemm { const bf16_t* A; const bf16_t* Bt; int M, N, K; const bf16_t* A1; const bf16_t* A2; };

struct StaticOrder {
    int nM, nN, nwg, G, c;
    __host__ __device__ void init(int M, int N, int G_, int c_) { nM = M / BM; nN = N / BM; nwg = nM * nN; G = G_; c = c_; }
    __host__ __device__ bool next(int i, Unit& u) const {
        const long L = (long)i * G + c; if (L >= nwg) return false;
        int wgid = (int)L; { const int q = nwg / NXCD, r = nwg % NXCD, xcd = wgid % NXCD, off = wgid / NXCD; wgid = (xcd < r ? xcd * (q + 1) : r * (q + 1) + (xcd - r) * q) + off; }
        const int nig = WGM * nN, gid = wgid / nig, fm = gid * WGM, gsz = (nM - fm) < WGM ? (nM - fm) : WGM;
        u.pm = fm + ((wgid % nig) % gsz); u.pn = (wgid % nig) / gsz; u.sel = 0; return true;
    }
    __device__ __forceinline__ const char* a_base(const Gemm& g, const Unit& u, size_t tstep) const { return (const char*)g.A + (size_t)u.pm * tstep; }
    __device__ __forceinline__ const char* b_base(const Gemm& g, const Unit& u, size_t tstep) const { return (const char*)g.Bt + (size_t)u.pn * tstep; }
};
struct BranchOrder {
    StaticOrder so;
    __host__ __device__ void init(int M, int N, int G_, int c_) { so.init(M, N, G_, c_); }
    __host__ __device__ bool next(int i, Unit& u) const { if (i >= 3) return false; if (!so.next(0, u)) return false; u.sel = i; return true; }
    __device__ __forceinline__ const char* a_base(const Gemm& g, const Unit& u, size_t tstep) const { const bf16_t* a = u.sel == 0 ? g.A : (u.sel == 1 ? g.A1 : g.A2); return (const char*)a + (size_t)u.pm * tstep; }
    __device__ __forceinline__ const char* b_base(const Gemm& g, const Unit& u, size_t tstep) const { return (const char*)g.Bt + (size_t)(u.sel * so.nN + u.pn) * tstep; }
};

__device__ __forceinline__ unsigned cvt_pk_bf16(float lo, float hi) { unsigned r; asm volatile("v_cvt_pk_bf16_f32 %0, %1, %2" : "=v"(r) : "v"(lo), "v"(hi)); return r; }
__device__ __forceinline__ float bf_lo(unsigned w) { return __builtin_bit_cast(float, w << 16); }
__device__ __forceinline__ float bf_hi(unsigned w) { return __builtin_bit_cast(float, w & 0xffff0000u); }
__device__ __forceinline__ float sigmoidf_(float x) { return 1.0f / (1.0f + __expf(-x)); }


struct EpiWin {
    static constexpr bool PERM = false, AFTER_DRAIN = false;
    bf16_t* Z; bf16_t* G; float* outk; float* outv; const float* rope;
    __device__ __forceinline__ void operator()(const f32x4 (&acc)[2][2][4][2], const Unit& u, int wr, int wc, int fr, int fq) const {
        const bool lat = u.pm >= 16;
        int rowb = u.pm * BM + wr * 64 + fr; asm volatile("" : "+v"(rowb));
#pragma unroll
        for (int bj = 0; bj < 2; ++bj) {
            const int c32 = u.pn * BM + bj * HALF + wc * 32;
            if (c32 >= 3072) {
#pragma unroll
                for (int ai = 0; ai < 2; ++ai)
#pragma unroll
                    for (int m = 0; m < 4; ++m) { bf16_t* gp = G + (size_t)(rowb + ai * HALF + m * 16) * 3072 + (c32 - 3072) + 4 * fq;
#pragma unroll
                        for (int n = 0; n < 2; ++n) { const f32x4 v = acc[ai][bj][m][n]; u32x2 w; w.x = cvt_pk_bf16(sigmoidf_(v[0]), sigmoidf_(v[1])); w.y = cvt_pk_bf16(sigmoidf_(v[2]), sigmoidf_(v[3])); *(u32x2*)(gp + 16 * n) = w; } }
            } else if (c32 >= 2848) {
            } else if (lat && c32 >= 2048 && c32 < 2688) {
                const float sc = c32 < 2560 ? 0.125f : 1.0f;
#pragma unroll
                for (int ai = 0; ai < 2; ++ai)
#pragma unroll
                    for (int m = 0; m < 4; ++m) { const int row = rowb + ai * HALF + m * 16, t = (row - 4096) & 1023, pos = (c32 & 32) ? (t & 63) : (t >> 6);
                        const f32x4* rp = (const f32x4*)(rope + (pos * 16 + 4 * fq) * 2); const f32x4 r0 = rp[0], r1 = rp[1];
                        const f32x4 x1 = acc[ai][bj][m][0] * sc, x2 = acc[ai][bj][m][1] * sc;
                        const f32x4 cs = (f32x4){r0[0], r0[2], r1[0], r1[2]}, sn = (f32x4){r0[1], r0[3], r1[1], r1[3]};
                        const f32x4 o1 = x1 * cs - x2 * sn, o2 = x1 * sn + x2 * cs;
                        bf16_t* zp = Z + (size_t)row * 2848 + c32 + 4 * fq;
                        u32x2 w; w.x = cvt_pk_bf16(o1[0], o1[1]); w.y = cvt_pk_bf16(o1[2], o1[3]); *(u32x2*)zp = w;
                        w.x = cvt_pk_bf16(o2[0], o2[1]); w.y = cvt_pk_bf16(o2[2], o2[3]); *(u32x2*)(zp + 16) = w; }
            } else {
                const float sc = ((c32 >= 512 && c32 < 768) || (c32 >= 2048 && c32 < 2560)) ? 0.125f : 1.0f;
                const bool kv32 = (!lat) && c32 >= 2560 && c32 < 2816;
                float* ob = c32 < 2688 ? outk : outv; const int cc = (c32 < 2688 ? c32 - 2560 : c32 - 2688) + 4 * fq;
#pragma unroll
                for (int ai = 0; ai < 2; ++ai)
#pragma unroll
                    for (int m = 0; m < 4; ++m) { const int row = rowb + ai * HALF + m * 16; bf16_t* zp = Z + (size_t)row * 2848 + c32 + 4 * fq;
#pragma unroll
                        for (int n = 0; n < 2; ++n) { const f32x4 v = acc[ai][bj][m][n] * sc; u32x2 w; w.x = cvt_pk_bf16(v[0], v[1]); w.y = cvt_pk_bf16(v[2], v[3]); *(u32x2*)(zp + 16 * n) = w;
                            if (kv32) *(f32x4*)(ob + (size_t)u.pm * 65536 + (size_t)(row & 255) * 128 + cc + 16 * n) = v; } }
            }
        }
    }
};
template <int MODE> struct EpiGlu {
    static constexpr bool PERM = true, AFTER_DRAIN = false;
    bf16_t* O; int ldc;
    __device__ __forceinline__ void operator()(const f32x4 (&acc)[2][2][4][2], const Unit& u, int wr, int wc, int fr, int fq) const {
        int row0 = u.pm * BM + wr * 64 + fr; asm volatile("" : "+v"(row0)); const int col0 = u.pn * HALF + wc * 32 + 8 * fq;
#pragma unroll
        for (int ai = 0; ai < 2; ++ai)
#pragma unroll
            for (int m = 0; m < 4; ++m) { bf16_t* rowp = O + (size_t)(row0 + ai * HALF + m * 16) * ldc + col0;
                f32x4 v[2];
#pragma unroll
                for (int n = 0; n < 2; ++n) { const f32x4 a = acc[ai][0][m][n], b = acc[ai][1][m][n];
#pragma unroll
                    for (int j = 0; j < 4; ++j) v[n][j] = MODE == 0 ? a[j] * sigmoidf_(b[j]) : a[j] * sigmoidf_(a[j]) * b[j]; }
                u32x4 w; w.x = cvt_pk_bf16(v[0][0], v[0][1]); w.y = cvt_pk_bf16(v[0][2], v[0][3]); w.z = cvt_pk_bf16(v[1][0], v[1][1]); w.w = cvt_pk_bf16(v[1][2], v[1][3]);
                *(u32x4*)rowp = w; }
    }
};
struct EpiBranch {
    static constexpr bool PERM = false, AFTER_DRAIN = false;
    const bf16_t* G; float* MF; bf16_t* MB;
    __device__ __forceinline__ void operator()(const f32x4 (&acc)[2][2][4][2], const Unit& u, int wr, int wc, int fr, int fq) const {
        int row0 = u.pm * BM + wr * 64 + fr; asm volatile("" : "+v"(row0)); const int col0 = u.pn * BM + wc * 32 + 4 * fq, sel = u.sel;
#pragma unroll
        for (int ai = 0; ai < 2; ++ai)
#pragma unroll
            for (int m = 0; m < 4; ++m) { const size_t row = (size_t)(row0 + ai * HALF + m * 16);
#pragma unroll
                for (int bj = 0; bj < 2; ++bj)
#pragma unroll
                    for (int n = 0; n < 2; ++n) { const int col = col0 + bj * HALF + n * 16;
                        const u32x2 gw = *(const u32x2*)(G + row * 3072 + sel * 1024 + col);
                        f32x4 v = acc[ai][bj][m][n] * (f32x4){bf_lo(gw.x), bf_hi(gw.x), bf_lo(gw.y), bf_hi(gw.y)};
                        if (sel > 0) v += *(const f32x4*)(MF + row * 1024 + col);
                        if (sel < 2) *(f32x4*)(MF + row * 1024 + col) = v;
                        else { u32x2 w; w.x = cvt_pk_bf16(v[0], v[1]); w.y = cvt_pk_bf16(v[2], v[3]); *(u32x2*)(MB + row * 1024 + col) = w; } } }
    }
};
struct EpiF32 {
    static constexpr bool PERM = false, AFTER_DRAIN = false;
    float* C; int ldc;
    __device__ __forceinline__ void operator()(const f32x4 (&acc)[2][2][4][2], const Unit& u, int wr, int wc, int fr, int fq) const {
        int row0 = u.pm * BM + wr * 64 + fr; asm volatile("" : "+v"(row0)); const int col0 = u.pn * BM + wc * 32 + 4 * fq;
#pragma unroll
        for (int ai = 0; ai < 2; ++ai)
#pragma unroll
            for (int m = 0; m < 4; ++m) { float* rowp = C + (size_t)(row0 + ai * HALF + m * 16) * ldc + col0;
#pragma unroll
                for (int bj = 0; bj < 2; ++bj)
#pragma unroll
                    for (int n = 0; n < 2; ++n) *(f32x4*)(rowp + bj * HALF + n * 16) = acc[ai][bj][m][n]; }
    }
};

template <class Epi, class Sched, bool ALIGN_EPI>
__device__ __forceinline__ void gemm_phase(PG8_LAS unsigned char* lds, const Gemm g, const Sched& S, const Epi& E, const int tid) {
    const int wid = __builtin_amdgcn_readfirstlane(tid >> 6), lane = tid & 63, wr = wid >> 2, wc = wid & 3, fr = lane & 15, fq = lane >> 4;
    const int K = g.K, nt = K / BK;
    unsigned voffA[2], voffB[2];
#pragma unroll
    for (int i = 0; i < 2; ++i) { int R, C; stage_rc(tid * 16 + i * 8192, R, C); const int Rb = Epi::PERM ? ((R & ~31) + perm32(R & 31)) : R;
        voffA[i] = (unsigned)(R * K + C) * 2u; voffB[i] = (unsigned)(Rb * K + C) * 2u; }
    const size_t kstep = (size_t)(BK * 2);
    const size_t hstep = (size_t)HALF * K * 2;
    const size_t tstep = 2 * hstep;
    const unsigned ldsw = (unsigned)wid * 1024u;
    const int aoff = lds_byte(wr * 64 + fr, fq * 8), boff = lds_byte(wc * 32 + fr, fq * 8);
#define PG8_SA(b, h) (((b) * 2 + (h)) * HTB)
#define PG8_SB(b, h) ((4 + (b) * 2 + (h)) * HTB)
#define PG8_STAGE(bufoff, gbase, voff) do { _Pragma("unroll") for (int _i = 0; _i < 2; ++_i) \
        __builtin_amdgcn_global_load_lds((const unsigned*)((const char*)(gbase) + (voff)[_i]), (PG8_LAS unsigned*)(lds + (bufoff) + ldsw + _i * 8192), 16, 0, 0); } while (0)
#define PG8_LDA(dst, b, h) do { _Pragma("unroll") for (int m = 0; m < 4; ++m) _Pragma("unroll") for (int k = 0; k < 2; ++k) dst[m][k] = *(const PG8_LAS bf16x8*)(lds + PG8_SA(b, h) + aoff + m * 2048 + k * 1024); } while (0)
#define PG8_LDB(dst, b, h) do { _Pragma("unroll") for (int n = 0; n < 2; ++n) _Pragma("unroll") for (int k = 0; k < 2; ++k) dst[n][k] = *(const PG8_LAS bf16x8*)(lds + PG8_SB(b, h) + boff + n * 2048 + k * 1024); } while (0)
#define PG8_MMA(ai, bj, At, Bt) do { __builtin_amdgcn_s_setprio(1); _Pragma("unroll") for (int m = 0; m < 4; ++m) _Pragma("unroll") for (int n = 0; n < 2; ++n) _Pragma("unroll") for (int k = 0; k < 2; ++k) \
        acc[ai][bj][m][n] = __builtin_amdgcn_mfma_f32_16x16x32_bf16(Bt[n][k], At[m][k], acc[ai][bj][m][n], 0, 0, 0); __builtin_amdgcn_s_setprio(0); } while (0)
#define PG8_WAIT_V(n) asm volatile("s_waitcnt vmcnt(" #n ")" ::: "memory")
#define PG8_WAIT_L(n) asm volatile("s_waitcnt lgkmcnt(" #n ")" ::: "memory")
#define PG8_BAR __builtin_amdgcn_s_barrier()
#define PG8_SCHED __builtin_amdgcn_sched_barrier(0)
    Unit cur, nxt; int ui = 0;
    if (!S.next(0, cur)) return;
    f32x4 acc[2][2][4][2];
#pragma unroll
    for (int a = 0; a < 2; ++a)
#pragma unroll
        for (int b = 0; b < 2; ++b)
#pragma unroll
            for (int m = 0; m < 4; ++m)
#pragma unroll
                for (int n = 0; n < 2; ++n) acc[a][b][m][n] = (f32x4){0.f, 0.f, 0.f, 0.f};
    bf16x8 At[4][2], B0[2][2], B1[2][2];
    const char* cA = S.a_base(g, cur, tstep); const char* cB = S.b_base(g, cur, tstep);
    PG8_STAGE(PG8_SB(0, 0), cB, voffB); PG8_STAGE(PG8_SB(0, 1), cB + hstep, voffB); PG8_STAGE(PG8_SA(0, 0), cA, voffA); PG8_STAGE(PG8_SA(0, 1), cA + hstep, voffA);
    if (wr == 1) PG8_BAR;
    PG8_WAIT_V(2); PG8_BAR;
    PG8_STAGE(PG8_SB(1, 0), cB + kstep, voffB); PG8_STAGE(PG8_SA(1, 0), cA + kstep, voffA); PG8_STAGE(PG8_SB(1, 1), cB + hstep + kstep, voffB);
    PG8_WAIT_V(6); PG8_BAR;
    for (;;) {
        const bool has_next = S.next(ui + 1, nxt);
        const char* nA = has_next ? S.a_base(g, nxt, tstep) : cA; const char* nB = has_next ? S.b_base(g, nxt, tstep) : cB;
        for (int t = 0; t < nt; t += 2) {
            const bool last = (t == nt - 2);
            const char* a1 = cA + (size_t)(t + 1) * kstep;
            const char* a2 = last ? nA : cA + (size_t)(t + 2) * kstep; const char* b2 = last ? nB : cB + (size_t)(t + 2) * kstep;
            const char* a3 = a2 + kstep; const char* b3 = b2 + kstep;
            PG8_LDB(B0, 0, 0); PG8_LDB(B1, 0, 1); PG8_SCHED; PG8_LDA(At, 0, 0); PG8_STAGE(PG8_SA(1, 1), a1 + hstep, voffA);
            PG8_WAIT_V(8); PG8_WAIT_L(0); PG8_BAR; PG8_MMA(0, 0, At, B0); PG8_MMA(0, 1, At, B1); PG8_BAR; PG8_SCHED;
            PG8_LDA(At, 0, 1); PG8_STAGE(PG8_SB(0, 0), b2, voffB); PG8_STAGE(PG8_SB(0, 1), b2 + hstep, voffB); PG8_STAGE(PG8_SA(0, 0), a2, voffA);
            PG8_WAIT_V(8); PG8_WAIT_L(0); PG8_BAR; PG8_MMA(1, 0, At, B0); PG8_MMA(1, 1, At, B1); PG8_BAR; PG8_SCHED;
            PG8_LDB(B0, 1, 0); PG8_LDB(B1, 1, 1); PG8_SCHED; PG8_LDA(At, 1, 0); PG8_STAGE(PG8_SA(0, 1), a2 + hstep, voffA);
            PG8_WAIT_V(8); PG8_WAIT_L(0); PG8_BAR; PG8_MMA(0, 0, At, B0); PG8_MMA(0, 1, At, B1); PG8_BAR; PG8_SCHED;
            PG8_LDA(At, 1, 1); PG8_STAGE(PG8_SB(1, 0), b3, voffB); PG8_STAGE(PG8_SB(1, 1), b3 + hstep, voffB); PG8_STAGE(PG8_SA(1, 0), a3, voffA);
            PG8_WAIT_V(8); PG8_WAIT_L(0); PG8_BAR; PG8_MMA(1, 0, At, B0); PG8_MMA(1, 1, At, B1); PG8_BAR; PG8_SCHED;
        }
        if constexpr (ALIGN_EPI) { if (wr == 0) PG8_BAR; }
        E(acc, cur, wr, wc, fr, fq);
        if (!has_next) break;
#pragma unroll
        for (int a = 0; a < 2; ++a)
#pragma unroll
            for (int b = 0; b < 2; ++b)
#pragma unroll
                for (int m = 0; m < 4; ++m)
#pragma unroll
                    for (int n = 0; n < 2; ++n) acc[a][b][m][n] = (f32x4){0.f, 0.f, 0.f, 0.f};
        cur = nxt; cA = nA; cB = nB; ++ui;
        if constexpr (ALIGN_EPI) { if (wr == 1) PG8_BAR; }
    }
    PG8_WAIT_V(0);
    if constexpr (!ALIGN_EPI) { if (wr == 0) PG8_BAR; }
    PG8_BAR;
#undef PG8_SA
#undef PG8_SB
#undef PG8_STAGE
#undef PG8_LDA
#undef PG8_LDB
#undef PG8_MMA
#undef PG8_WAIT_V
#undef PG8_WAIT_L
#undef PG8_BAR
#undef PG8_SCHED
}
}

constexpr int NWAVES = 8;
constexpr int DM = 1024, M_CTX = 4096, M_TOK = 12288, L_CTX = 256, L_LAT = 1024;
constexpr int ZP = 2848, GP = 3072, NZ = 6144, D_IN = 5920, FFH = 2816, FF2 = 5632;
constexpr float RMS_EPS = 1e-6f;
constexpr size_t O_Y = 0, O_CK = 12582912, O_CV = 13631488, O_S5 = 14680064, O_GLA = 14942208, O_END = 17039360;
enum { I_XP = 0, I_XS, I_CK, I_CV, I_SS5, I_SGLA, I_C, I_CCTX, I_WMOD, I_BMOD, I_NORMG, I_WIN, I_LRE, I_LIM, I_LSTEP, I_BRE, I_BIM, I_CRE, I_CIM, I_S5D, I_WGLU, I_WGK, I_BGK, I_GNG, I_SINK, I_WBR, I_WOUT, I_W1, I_W2, N_IN };

constexpr size_t MiB = 1u << 20;
constexpr size_t WS_CTL = 0, CTL_ZERO_BYTES = 64 * 1024;
constexpr size_t WS_MOD = 64 * 1024;
constexpr size_t WS_ROPE = 512 * 1024;
constexpr size_t WS_CKV = 1 * MiB;
constexpr size_t WS_W = 3 * MiB;
constexpr size_t WS_XN = 38 * MiB;
constexpr size_t WS_Z = 62 * MiB;
constexpr size_t WS_G = 129 * MiB;
constexpr size_t WS_GS = 201 * MiB;
constexpr size_t WS_Y = 225 * MiB;
constexpr size_t WS_END = 249 * MiB;
constexpr size_t WO_IN = 0, WO_GLU = 6291456, WO_BR = 6815744, WO_OUT = 8388608, WO_W1 = 9437184, WO_W2 = 15204352, WO_END = 18087936;
static_assert(WS_W + WO_END * 2 <= WS_XN && WS_XN + (size_t)M_TOK * 1024 * 2 <= WS_Z && WS_Z + (size_t)M_TOK * ZP * 2 <= WS_G && WS_G + (size_t)M_TOK * GP * 2 <= WS_GS && WS_GS + (size_t)M_TOK * 1024 * 2 <= WS_Y && WS_Y + (size_t)M_TOK * 1024 * 2 <= WS_END, "d_ws map");
constexpr int CW_BAR = 1024;

constexpr int RING_OFF = 0, RING_BYTES = 131072;
constexpr int LDSCTL_OFF = RING_BYTES, MISC_OFF = LDSCTL_OFF + 320;
constexpr int LDS_BYTES = 147456;
static_assert(MISC_OFF + 128 <= LDS_BYTES, "LDS map");

#define GAS __attribute__((address_space(1)))
#define LAS __attribute__((address_space(3)))
typedef unsigned short bf16;
typedef unsigned v4u __attribute__((ext_vector_type(4)));
typedef unsigned v2u __attribute__((ext_vector_type(2)));
typedef float f32x4 __attribute__((ext_vector_type(4)));
#define LDS_WAIT() asm volatile("s_waitcnt lgkmcnt(0)" ::: "memory")
__device__ __forceinline__ unsigned f2bf(float f) { unsigned u = __builtin_bit_cast(unsigned, f); return (u + 0x7fffu + ((u >> 16) & 1u)) >> 16; }
__device__ __forceinline__ unsigned pk2(float lo, float hi) { return f2bf(lo) | (f2bf(hi) << 16); }
__device__ __forceinline__ float bf2f(bf16 b) { return __builtin_bit_cast(float, ((unsigned)b) << 16); }
__device__ __forceinline__ float bflo(unsigned w) { return __builtin_bit_cast(float, w << 16); }
__device__ __forceinline__ float bfhi(unsigned w) { return __builtin_bit_cast(float, w & 0xffff0000u); }

#define XB_TMO      128
#define XB_XCNT(j)  (256  + 64 * (j))
#define XB_XSUB(j)  (1280 + 64 * (j))
#define XB_XGEN(j)  (2304 + 64 * (j))
#define XB_TOP      3328
#define XB_TOPGEN   3392
#define XCD_BAR_WORDS 3456
#define XB_SPIN_CAP (1u << 22)

__device__ __forceinline__ unsigned xb_ld(unsigned* p)              { return __hip_atomic_load(p, __ATOMIC_RELAXED, __HIP_MEMORY_SCOPE_AGENT); }
__device__ __forceinline__ unsigned xb_add(unsigned* p, unsigned v) { return __hip_atomic_fetch_add(p, v, __ATOMIC_RELAXED, __HIP_MEMORY_SCOPE_AGENT); }
__device__ __forceinline__ unsigned xb_xcc_id() { return (unsigned)__builtin_amdgcn_s_getreg((3 << 11) | 20) & 0xFu; }
#define XB_SPIN(cond, bar) do { unsigned _sp = 0; while (cond) { __builtin_amdgcn_s_sleep(1); \
    if ((++_sp & 255u) == 0u) { if (xb_ld(&(bar)[XB_TMO])) break; if (_sp > XB_SPIN_CAP) { atomicAdd(&(bar)[XB_TMO], 1u); break; } } } } while (0)

struct XcdBarrier {
    unsigned* bar; unsigned x;
    volatile LAS unsigned* st;
};

__device__ __forceinline__ XcdBarrier xcd_barrier_post(unsigned* bar, volatile LAS unsigned* st) {
    XcdBarrier b; b.bar = bar; b.x = xb_xcc_id(); b.st = st;
    if (threadIdx.x == 0) (void)xb_add(&bar[XB_XCNT(b.x)], 1u);
    return b;
}
__device__ __forceinline__ void xcd_barrier_complete(unsigned* bar, unsigned x, unsigned& nloc, unsigned& nx) {
    const unsigned G = gridDim.x * gridDim.y * gridDim.z;
    unsigned sum, cnt, mine, sp = 0u;
    for (;;) {
        sum = 0u; cnt = 0u; mine = 0u;
#pragma unroll
        for (unsigned j = 0; j < 16; ++j) { const unsigned c = xb_ld(&bar[XB_XCNT(j)]); sum += c; cnt += (c > 0u) ? 1u : 0u; mine = (j == x) ? c : mine; }
        if (sum == G) break;
        __builtin_amdgcn_s_sleep(1);
        if ((++sp & 255u) == 0u) { if (xb_ld(&bar[XB_TMO])) break; if (sp > XB_SPIN_CAP) { atomicAdd(&bar[XB_TMO], 1u); break; } }
    }
    nloc = mine > 0u ? mine : 1u; nx = cnt > 0u ? cnt : 1u;
}

__device__ __forceinline__ void xcd_barrier(const XcdBarrier& b) {
    asm volatile("s_waitcnt vmcnt(0)" ::: "memory");
    __syncthreads();
    if (threadIdx.x == 0) {
        unsigned* bar = b.bar;
        __builtin_amdgcn_s_waitcnt(0);
        unsigned nloc = b.st[0], nx = b.st[1];
        if (nloc == 0u) { xcd_barrier_complete(bar, b.x, nloc, nx); b.st[0] = nloc; b.st[1] = nx; }
        const unsigned old = xb_add(&bar[XB_XSUB(b.x)], 1u);
        const unsigned gen = old / nloc;
        if (old + 1u == (gen + 1u) * nloc) {
            __builtin_amdgcn_fence(__ATOMIC_RELEASE, "agent");
            asm volatile("s_waitcnt vmcnt(0)" ::: "memory");
            const unsigned og = xb_add(&bar[XB_TOP], 1u);
            const unsigned tg = og / nx;
            if (og + 1u == (tg + 1u) * nx) xb_add(&bar[XB_TOPGEN], 1u);
            else XB_SPIN(xb_ld(&bar[XB_TOPGEN]) == tg, bar);
            __builtin_amdgcn_fence(__ATOMIC_ACQUIRE, "agent");
            xb_add(&bar[XB_XGEN(b.x)], 1u);
            asm volatile("s_waitcnt vmcnt(0)" ::: "memory");
        } else {
            XB_SPIN(xb_ld(&bar[XB_XGEN(b.x)]) == gen, bar);
            __builtin_amdgcn_fence(__ATOMIC_ACQUIRE, "agent");
            asm volatile("s_waitcnt vmcnt(0)" ::: "memory");
        }
    }
    __syncthreads();
}


struct Args { const float* in[N_IN]; float* out; unsigned char* ws; int ph_lo, ph_hi; };
static_assert(sizeof(Args) == (N_IN + 2) * 8 + 8, "Args has no padding");
typedef const float* cfptr_t;
typedef const __attribute__((address_space(4))) cfptr_t* kargs_t;
struct Frame {
    unsigned char* lds;
    int tid, lane, wave, G, bid;
    kargs_t in; float* out; unsigned char* ws;
};
__device__ __forceinline__ float wave_sum(float v) {
#pragma unroll
    for (int o = 1; o < 64; o <<= 1) v += __shfl_xor(v, o);
    return v;
}
__device__ __forceinline__ const float* xin_row(const Frame& F, int row) { return row < M_CTX ? F.in[I_XP] + (size_t)row * DM : F.in[I_XS] + (size_t)(row - M_CTX) * DM; }
__device__ __forceinline__ int path_of(int row) { return row < M_CTX ? 0 : 1 + ((row - M_CTX) >> 10); }

__device__ __forceinline__ int map_row(int mapk, int n0) {
    if (mapk == 0) return n0;
    if (mapk == 1) { if (n0 < 2048) return n0; if (n0 < 2080) return 2816 + (n0 - 2048); if (n0 < 2848) return 2048 + (n0 - 2080); return 3072 + (n0 - 2848); }
    const int half = mapk == 2 ? 512 : 2816;
    if (n0 < half) return (n0 / 128) * 256 + (n0 % 128);
    const int s = n0 - half; return (s / 128) * 256 + 128 + (s % 128);
}
__device__ __forceinline__ void p0_transpose_item(const float* W, int K, int N, bf16* WT, int mapk, float* scr, int item, int lane) {
    const int nblk = N / 32, kb = item / nblk, nb = item % nblk, k0 = 64 * kb, n0 = 32 * nb, d0 = map_row(mapk, n0);
#pragma unroll 8
    for (int i = 0; i < 32; ++i) { const int kk = 2 * i + (lane >> 5); scr[kk * 33 + (lane & 31)] = W[(size_t)(k0 + kk) * N + n0 + (lane & 31)]; }
    LDS_WAIT(); asm volatile("" ::: "memory");
    const int c = lane & 7;
#pragma unroll
    for (int j = 0; j < 4; ++j) { const int n = (lane >> 3) + 8 * j; const float* s = scr + (8 * c) * 33 + n;
        v4u o; o.x = pk2(s[0 * 33], s[1 * 33]); o.y = pk2(s[2 * 33], s[3 * 33]); o.z = pk2(s[4 * 33], s[5 * 33]); o.w = pk2(s[6 * 33], s[7 * 33]);
        *(v4u*)(WT + (size_t)(d0 + n) * K + k0 + 8 * c) = o; }
    LDS_WAIT(); asm volatile("" ::: "memory");
}
__device__ __forceinline__ void convert_weights(const Frame& F, int l) {
    float* scr = (float*)(F.lds + RING_OFF + F.wave * 16384);
    bf16* WT = (bf16*)(F.ws + WS_W);
    const int gw = F.bid * NWAVES + F.wave, NGW = F.G * NWAVES;
    constexpr int I0 = 16 * 185, I1 = 8 * 32, I2 = 3 * 8 * 32, I3 = 16 * 32, I4 = 16 * 176, I5 = 44 * 32;
    for (int it = gw; it < I0 + I1 + I2 + I3 + I4 + I5; it += NGW) {
        int r = it;
        if (r < I0) { p0_transpose_item(F.in[I_WIN] + (size_t)l * 1024 * D_IN, 1024, D_IN, WT + WO_IN, 1, scr, r, F.lane); continue; } r -= I0;
        if (r < I1) { p0_transpose_item(F.in[I_WGLU] + (size_t)l * 512 * 1024, 512, 1024, WT + WO_GLU, 2, scr, r, F.lane); continue; } r -= I1;
        if (r < I2) { const int n = r / 256; p0_transpose_item(F.in[I_WBR] + (size_t)(l * 3 + n) * 512 * 1024, 512, 1024, WT + WO_BR + (size_t)n * 1024 * 512, 0, scr, r % 256, F.lane); continue; } r -= I2;
        if (r < I3) { p0_transpose_item(F.in[I_WOUT] + (size_t)l * 1024 * 1024, 1024, 1024, WT + WO_OUT, 0, scr, r, F.lane); continue; } r -= I3;
        if (r < I4) { p0_transpose_item(F.in[I_W1] + (size_t)l * 1024 * FF2, 1024, FF2, WT + WO_W1, 3, scr, r, F.lane); continue; } r -= I4;
        p0_transpose_item(F.in[I_W2] + (size_t)l * FFH * 1024, FFH, 1024, WT + WO_W2, 0, scr, r, F.lane);
    }
}
__device__ __forceinline__ void mod_items(const Frame& F) {
    float* SC = (float*)(F.lds);
    float* RED = (float*)(F.lds + 40960);
    float* MOD = (float*)(F.ws + WS_MOD);
    if (F.bid >= 192) return;
    for (int i = F.tid; i < 9 * 1024; i += NWAVES * 64) { const float c = i < 1024 ? F.in[I_CCTX][i] : F.in[I_C][i - 1024]; SC[i] = c / (1.0f + __expf(-c)); }
    __syncthreads();
    const int item = F.bid, l = item / 96, col = (item % 96) * 64 + F.lane;
    const float* wm = F.in[I_WMOD] + ((size_t)l * 1024 + F.wave * 128) * 6144 + col;
    float acc[9];
#pragma unroll
    for (int r = 0; r < 9; ++r) acc[r] = 0.f;
#pragma unroll 8
    for (int kk = 0; kk < 128; ++kk) { const float wv = wm[(size_t)kk * 6144]; const int k = F.wave * 128 + kk;
#pragma unroll
        for (int r = 0; r < 9; ++r) acc[r] += SC[r * 1024 + k] * wv; }
#pragma unroll
    for (int r = 0; r < 9; ++r) RED[(F.wave * 9 + r) * 64 + F.lane] = acc[r];
    __syncthreads();
    for (int o = F.tid; o < 576; o += NWAVES * 64) { const int r = o >> 6, ln = o & 63; float s = F.in[I_BMOD][l * 6144 + (item % 96) * 64 + ln];
#pragma unroll
        for (int w = 0; w < 8; ++w) s += RED[(w * 9 + r) * 64 + ln];
        MOD[(size_t)(l * 9 + r) * 6144 + (item % 96) * 64 + ln] = s; }
    __syncthreads();
}
__device__ __forceinline__ void p0_prologue(const Frame& F) {
    mod_items(F);
    const int gt = F.bid * (NWAVES * 64) + F.tid, NGT = F.G * NWAVES * 64;
    if (gt < 1024) { const int pos = gt >> 4, q = gt & 15; const float inv = powf(10000.0f, -(float)q / 16.0f), ang = (float)pos * inv; float* rp = (float*)(F.ws + WS_ROPE); rp[gt * 2] = cosf(ang); rp[gt * 2 + 1] = sinf(ang); }
    { bf16* ck = (bf16*)(F.ws + WS_CKV); bf16* cv = ck + 524288;
      for (int i = gt; i < 524288; i += NGT) { const int c = i & 127, j = (i >> 7) & 255, b = (i >> 15) & 7, l = i >> 18; const size_t s = ((size_t)((b * 2 + l) * 256 + j)) * 128 + c;
          ck[i] = (bf16)f2bf(F.in[I_CK][s]); cv[i] = (bf16)f2bf(F.in[I_CV][s]); } }
    convert_weights(F, 0);
}

__device__ __forceinline__ void norm_phase(const Frame& F, int l, int mode) {
    const int gw = F.bid * NWAVES + F.wave, NGW = F.G * NWAVES;
    const float* MOD = (const float*)(F.ws + WS_MOD);
    const float* RAW = (const float*)(F.ws + WS_Z);
    bf16* XN = (bf16*)(F.ws + WS_XN);
    float* X = F.out + O_Y;
    for (int row = gw; row < M_TOK; row += NGW) {
        const int pb = path_of(row);
        const float* modl = MOD + (size_t)(l * 9 + pb) * 6144;
        const float* ng = F.in[I_NORMG] + l * 4096;
        const float* xs = (mode == 2 || l == 1) ? X + (size_t)row * DM : xin_row(F, row);
        f32x4 xv[4];
#pragma unroll
        for (int j = 0; j < 4; ++j) xv[j] = ((const f32x4*)xs)[F.lane + 64 * j];
        if (mode >= 1) {
            f32x4 rv[4]; float ss = 0.f;
#pragma unroll
            for (int j = 0; j < 4; ++j) { rv[j] = ((const f32x4*)(RAW + (size_t)row * DM))[F.lane + 64 * j]; ss += rv[j].x * rv[j].x + rv[j].y * rv[j].y + rv[j].z * rv[j].z + rv[j].w * rv[j].w; }
            const float rstd = 1.0f / sqrtf(wave_sum(ss) * (1.0f / DM) + RMS_EPS);
            const float* gate = modl + (mode == 1 ? 2048 : 5120); const float* nga = ng + (mode == 1 ? 1024 : 3072);
#pragma unroll
            for (int j = 0; j < 4; ++j) { const f32x4 gv = ((const f32x4*)gate)[F.lane + 64 * j], nv = ((const f32x4*)nga)[F.lane + 64 * j]; xv[j] = xv[j] + gv * (rv[j] * rstd * nv); ((f32x4*)(X + (size_t)row * DM))[F.lane + 64 * j] = xv[j]; }
        }
        if (mode == 2 && l == 1) continue;
        const int ln = mode == 2 ? l + 1 : l;
        const float* modn = MOD + (size_t)(ln * 9 + pb) * 6144;
        const float* ngb = F.in[I_NORMG] + ln * 4096 + (mode == 1 ? 2048 : 0);
        const float* sc = modn + (mode == 1 ? 4096 : 1024); const float* sh = modn + (mode == 1 ? 3072 : 0);
        float ss = 0.f;
#pragma unroll
        for (int j = 0; j < 4; ++j) ss += xv[j].x * xv[j].x + xv[j].y * xv[j].y + xv[j].z * xv[j].z + xv[j].w * xv[j].w;
        const float rstd = 1.0f / sqrtf(wave_sum(ss) * (1.0f / DM) + RMS_EPS);
#pragma unroll
        for (int j = 0; j < 4; ++j) { const f32x4 nv = ((const f32x4*)ngb)[F.lane + 64 * j], sv = ((const f32x4*)sc)[F.lane + 64 * j], hv = ((const f32x4*)sh)[F.lane + 64 * j];
            const f32x4 o = xv[j] * rstd * nv * (sv + 1.0f) + hv; v2u w; w.x = pk2(o.x, o.y); w.y = pk2(o.z, o.w); ((v2u*)(XN + (size_t)row * DM))[F.lane + 64 * j] = w; }
    }
}

__device__ __forceinline__ float gelu_tanh(float x) { const float u = 0.7978845608028654f * (x + 0.044715f * x * x * x); return 0.5f * x * (1.0f + tanhf(u)); }
__device__ __forceinline__ void s5_item(const Frame& F, int l, int item) {
    const int w = F.wave, lane = F.lane, pair = item * 4 + (w >> 1), d = w & 1;
    const bool lat = pair < 256; const int pp = lat ? pair : pair - 256, b = pp >> 5, g = pp & 31;
    const int L = lat ? L_LAT : L_CTX, row0 = lat ? M_CTX + b * L_LAT : b * L_CTX;
    const bf16* Z = (const bf16*)(F.ws + WS_Z); bf16* SS = (bf16*)(F.ws + WS_XN);
    {
        const int pidx = ((l * 2 + d) * 32 + g) * 64 + lane;
        const float lre = F.in[I_LRE][pidx], lim = F.in[I_LIM][pidx], dt = expf(F.in[I_LSTEP][pidx]);
        const float mag = expf(lre * dt); float sn, cs; sincosf(lim * dt, &sn, &cs);
        const float ar = mag * cs, ai = mag * sn, nr = ar - 1.0f, ni = ai, den = lre * lre + lim * lim;
        const float fr = (nr * lre + ni * lim) / den, fi = (ni * lre - nr * lim) / den;
        float Bre[16], Bim[16], Cre[16], Cim[16];
#pragma unroll
        for (int s = 0; s < 16; ++s) { const float br = F.in[I_BRE][(size_t)pidx * 16 + s], bi = F.in[I_BIM][(size_t)pidx * 16 + s]; Bre[s] = fr * br - fi * bi; Bim[s] = fr * bi + fi * br;
            const size_t ci = ((size_t)(((l * 2 + d) * 32 + g) * 16 + s)) * 64 + lane; Cre[s] = F.in[I_CRE][ci]; Cim[s] = F.in[I_CIM][ci]; }
        float hr = 0.f, hi = 0.f;
        if (lat) { const size_t si = ((size_t)((((b * 2 + l) * 2 + d) * 32 + g) * 64 + lane)) * 2; hr = F.in[I_SS5][si]; hi = F.in[I_SS5][si + 1]; }
        bf16* scr = SS + (size_t)d * M_TOK * 512;
        for (int tt = 0; tt < L; ++tt) {
            const int t = d ? L - 1 - tt : tt; const size_t row = (size_t)(row0 + t);
            const v4u* up = (const v4u*)(Z + row * ZP + g * 16); const v4u u0 = up[0], u1 = up[1];
            float u[16];
            u[0] = bflo(u0.x); u[1] = bfhi(u0.x); u[2] = bflo(u0.y); u[3] = bfhi(u0.y); u[4] = bflo(u0.z); u[5] = bfhi(u0.z); u[6] = bflo(u0.w); u[7] = bfhi(u0.w);
            u[8] = bflo(u1.x); u[9] = bfhi(u1.x); u[10] = bflo(u1.y); u[11] = bfhi(u1.y); u[12] = bflo(u1.z); u[13] = bfhi(u1.z); u[14] = bflo(u1.w); u[15] = bfhi(u1.w);
            float bur = 0.f, bui = 0.f;
#pragma unroll
            for (int s = 0; s < 16; ++s) { bur += Bre[s] * u[s]; bui += Bim[s] * u[s]; }
            const float nhr = ar * hr - ai * hi + bur, nhi = ar * hi + ai * hr + bui; hr = nhr; hi = nhi;
            float v[16];
#pragma unroll
            for (int s = 0; s < 16; ++s) v[s] = Cre[s] * hr - Cim[s] * hi;
#pragma unroll
            for (int j = 0; j < 8; ++j) { const bool hb = (lane & 32) != 0; const float keep = hb ? v[j + 8] : v[j], send = hb ? v[j] : v[j + 8]; v[j] = keep + __shfl_xor(send, 32); }
#pragma unroll
            for (int j = 0; j < 4; ++j) { const bool hb = (lane & 16) != 0; const float keep = hb ? v[j + 4] : v[j], send = hb ? v[j] : v[j + 4]; v[j] = keep + __shfl_xor(send, 16); }
#pragma unroll
            for (int j = 0; j < 2; ++j) { const bool hb = (lane & 8) != 0; const float keep = hb ? v[j + 2] : v[j], send = hb ? v[j] : v[j + 2]; v[j] = keep + __shfl_xor(send, 8); }
            { const bool hb = (lane & 4) != 0; const float keep = hb ? v[1] : v[0], send = hb ? v[0] : v[1]; v[0] = keep + __shfl_xor(send, 4); }
            v[0] += __shfl_xor(v[0], 2); v[0] += __shfl_xor(v[0], 1);
            if ((lane & 3) == 0) scr[row * 512 + g * 16 + (lane >> 2)] = (bf16)f2bf(v[0]);
        }
        if (!lat) { float* so = F.out + O_S5 + ((size_t)((((b * 2 + l) * 2 + d) * 32 + g) * 64 + lane)) * 2; so[0] = hr; so[1] = hi; }
    }
    __syncthreads();
    const float* Dp = F.in[I_S5D] + l * 512;
    for (int idx = F.tid; idx < 4 * L * 16; idx += NWAVES * 64) {
        const int pl = idx / (L * 16), rem = idx - pl * L * 16, t = rem >> 4, s = rem & 15;
        const int p2 = item * 4 + pl, pp2 = lat ? p2 : p2 - 256, b2 = pp2 >> 5, g2 = pp2 & 31;
        const size_t row = (size_t)((lat ? M_CTX + b2 * L_LAT : b2 * L_CTX) + t); const int col = g2 * 16 + s;
        const float y = bf2f(SS[row * 512 + col]) + bf2f(SS[(size_t)M_TOK * 512 + row * 512 + col]) + Dp[col] * bf2f(Z[row * ZP + col]);
        SS[row * 512 + col] = (bf16)f2bf(gelu_tanh(y));
    }
    __syncthreads();
}
__device__ __forceinline__ void gla_item(const Frame& F, int l, int item) {
    const bool lat = item < 32; const int ii = lat ? item : item - 32, b = ii >> 2, h = ii & 3;
    const int L = lat ? L_LAT : L_CTX, row0 = lat ? M_CTX + b * L_LAT : b * L_CTX;
    const int d = F.tid >> 8, ht = F.tid & 255, dv = ht & 127, kg = ht >> 7;
    const bf16* Z = (const bf16*)(F.ws + WS_Z); bf16* GS = (bf16*)(F.ws + WS_GS); bf16* YB = (bf16*)(F.ws + WS_Y);
    float* sm = (float*)(F.lds) + d * 1024;
    float S[32];
#pragma unroll
    for (int i = 0; i < 32; ++i) S[i] = lat ? F.in[I_SGLA][((size_t)((((b * 2 + l) * 2 + d) * 4 + h) * 64 + kg * 32 + i)) * 128 + dv] : 0.f;
    float wg[16], bg = 0.f;
#pragma unroll
    for (int r = 0; r < 16; ++r) wg[r] = 0.f;
    if (ht < 64) {
#pragma unroll
        for (int r = 0; r < 16; ++r) wg[r] = F.in[I_WGK][((size_t)((l * 2 + d) * 16 + r)) * 256 + h * 64 + ht];
        bg = F.in[I_BGK][(l * 2 + d) * 256 + h * 64 + ht];
    }
    for (int tt = 0; tt < L; ++tt) {
        const int t = d ? L - 1 - tt : tt; const size_t row = (size_t)(row0 + t); const bf16* zr = Z + row * ZP;
        if (ht < 64) {
            const v4u* lp = (const v4u*)(zr + 2816 + d * 16); const v4u a0 = lp[0], a1 = lp[1];
            float x = bg;
            x += wg[0] * bflo(a0.x) + wg[1] * bfhi(a0.x) + wg[2] * bflo(a0.y) + wg[3] * bfhi(a0.y) + wg[4] * bflo(a0.z) + wg[5] * bfhi(a0.z) + wg[6] * bflo(a0.w) + wg[7] * bfhi(a0.w);
            x += wg[8] * bflo(a1.x) + wg[9] * bfhi(a1.x) + wg[10] * bflo(a1.y) + wg[11] * bfhi(a1.y) + wg[12] * bflo(a1.z) + wg[13] * bfhi(a1.z) + wg[14] * bflo(a1.w) + wg[15] * bfhi(a1.w);
            const float ls = fminf(x, 0.f) - log1pf(expf(-fabsf(x)));
            sm[128 + ht] = expf(ls * 0.0625f); sm[ht] = bf2f(zr[512 + h * 64 + ht]); sm[64 + ht] = bf2f(zr[768 + h * 64 + ht]);
        } else if (ht < 192) sm[192 + ht - 64] = bf2f(zr[1024 + h * 128 + ht - 64]);
        __syncthreads();
        const float vv = sm[192 + dv]; float op = 0.f;
#pragma unroll
        for (int i = 0; i < 32; ++i) { const int dk = kg * 32 + i; S[i] = S[i] * sm[128 + dk] + sm[64 + dk] * vv; op += sm[dk] * S[i]; }
        sm[320 + kg * 128 + dv] = op;
        __syncthreads();
        if (kg == 0) GS[(size_t)d * M_TOK * 512 + row * 512 + h * 128 + dv] = (bf16)f2bf(sm[320 + dv] + sm[448 + dv]);
    }
    if (!lat) {
#pragma unroll
        for (int i = 0; i < 32; ++i) F.out[O_GLA + ((size_t)((((b * 2 + l) * 2 + d) * 4 + h) * 64 + kg * 32 + i)) * 128 + dv] = S[i];
    }
    __syncthreads();
    for (int t = F.wave; t < L; t += NWAVES) {
        const size_t row = (size_t)(row0 + t); const int c = h * 128 + 2 * F.lane;
        const unsigned a = *(const unsigned*)(GS + row * 512 + c), bb = *(const unsigned*)(GS + (size_t)M_TOK * 512 + row * 512 + c), gg = *(const unsigned*)(Z + row * ZP + 1536 + c);
        const float o0 = bflo(a) + bflo(bb), o1 = bfhi(a) + bfhi(bb);
        const float rstd = 1.0f / sqrtf(wave_sum(o0 * o0 + o1 * o1) * (1.0f / 128.0f) + RMS_EPS);
        const float g0 = bflo(gg), g1 = bfhi(gg);
        const float* gn = F.in[I_GNG] + l * 128 + 2 * F.lane;
        *(unsigned*)(YB + row * 512 + c) = pk2(o0 * rstd * gn[0] * (g0 / (1.0f + __expf(-g0))), o1 * rstd * gn[1] * (g1 / (1.0f + __expf(-g1))));
    }
    __syncthreads();
}
__device__ __forceinline__ void attn_key(float (&q)[64], float (&o)[64], float& m, float& ls, const bf16* kp, const bf16* vp, bool valid) {
    float s = 0.f;
#pragma unroll
    for (int c = 0; c < 8; ++c) { const v4u kw = ((const v4u*)kp)[c];
        s += q[8 * c] * bflo(kw.x) + q[8 * c + 1] * bfhi(kw.x) + q[8 * c + 2] * bflo(kw.y) + q[8 * c + 3] * bfhi(kw.y) + q[8 * c + 4] * bflo(kw.z) + q[8 * c + 5] * bfhi(kw.z) + q[8 * c + 6] * bflo(kw.w) + q[8 * c + 7] * bfhi(kw.w); }
    if (!valid) s = -INFINITY;
    const float mn = fmaxf(m, s), al = __expf(m - mn), p = __expf(s - mn);
    ls = ls * al + p; m = mn;
#pragma unroll
    for (int c = 0; c < 8; ++c) { const v4u vw = ((const v4u*)vp)[c];
        o[8 * c] = o[8 * c] * al + p * bflo(vw.x); o[8 * c + 1] = o[8 * c + 1] * al + p * bfhi(vw.x); o[8 * c + 2] = o[8 * c + 2] * al + p * bflo(vw.y); o[8 * c + 3] = o[8 * c + 3] * al + p * bfhi(vw.y);
        o[8 * c + 4] = o[8 * c + 4] * al + p * bflo(vw.z); o[8 * c + 5] = o[8 * c + 5] * al + p * bfhi(vw.z); o[8 * c + 6] = o[8 * c + 6] * al + p * bflo(vw.w); o[8 * c + 7] = o[8 * c + 7] * al + p * bfhi(vw.w); }
}
__device__ __forceinline__ void attn_item(const Frame& F, int l, int item) {
    const bool lat = item < 128; const int ii = lat ? item : item - 128;
    const int b = lat ? ii >> 4 : ii >> 2, qb = lat ? ii & 15 : ii & 3;
    const int row0 = lat ? M_CTX + b * L_LAT : b * L_CTX, h = F.wave, kvh = h >> 2, t = qb * 64 + F.lane;
    const bf16* Z = (const bf16*)(F.ws + WS_Z); bf16* YC = (bf16*)(F.ws + WS_Y) + (size_t)M_TOK * 512;
    float q[64], o[64];
    { const v4u* qp = (const v4u*)(Z + (size_t)(row0 + t) * ZP + 2048 + h * 64);
#pragma unroll
      for (int c = 0; c < 8; ++c) { const v4u w = qp[c]; q[8 * c] = bflo(w.x); q[8 * c + 1] = bfhi(w.x); q[8 * c + 2] = bflo(w.y); q[8 * c + 3] = bfhi(w.y); q[8 * c + 4] = bflo(w.z); q[8 * c + 5] = bfhi(w.z); q[8 * c + 6] = bflo(w.w); q[8 * c + 7] = bfhi(w.w); } }
#pragma unroll
    for (int c = 0; c < 64; ++c) o[c] = 0.f;
    float m = F.in[I_SINK][l * 8 + h], ls = 1.0f;
    if (lat) {
        const int j0 = qb * 64 - 128 < 0 ? 0 : qb * 64 - 128, j1 = qb * 64 + 191 > L_LAT - 1 ? L_LAT - 1 : qb * 64 + 191;
        for (int j = j0; j <= j1; ++j) { const bf16* zr = Z + (size_t)(row0 + j) * ZP; const int dj = t - j; attn_key(q, o, m, ls, zr + 2560 + kvh * 64, zr + 2688 + kvh * 64, dj <= 128 && dj >= -128); }
        const bf16* ck = (const bf16*)(F.ws + WS_CKV) + (size_t)((l * 8 + b) * 256) * 128; const bf16* cv = ck + 524288;
        for (int j = 0; j < 256; ++j) attn_key(q, o, m, ls, ck + (size_t)j * 128 + kvh * 64, cv + (size_t)j * 128 + kvh * 64, true);
    } else {
        for (int j = 0; j < L_CTX; ++j) { const bf16* zr = Z + (size_t)(row0 + j) * ZP; attn_key(q, o, m, ls, zr + 2560 + kvh * 64, zr + 2688 + kvh * 64, true); }
    }
    const float inv = 1.0f / ls;
    v4u* op = (v4u*)(YC + (size_t)(row0 + t) * 512 + h * 64);
#pragma unroll
    for (int c = 0; c < 8; ++c) { v4u w; w.x = pk2(o[8 * c] * inv, o[8 * c + 1] * inv); w.y = pk2(o[8 * c + 2] * inv, o[8 * c + 3] * inv); w.z = pk2(o[8 * c + 4] * inv, o[8 * c + 5] * inv); w.w = pk2(o[8 * c + 6] * inv, o[8 * c + 7] * inv); op[c] = w; }
}
__device__ __forceinline__ void mixer_phase(const Frame& F, int l) {
    for (int it = F.bid; it < 480; it += F.G) {
        if (it < 192) s5_item(F, l, it);
        else if (it < 288) gla_item(F, l, it - 192);
        else attn_item(F, l, it - 288);
    }
}

constexpr int N_PHASES = 20;
__global__ void __launch_bounds__(NWAVES * 64, 2) fwd_kernel(Args args) {
    extern __shared__ __attribute__((aligned(16))) unsigned char lds[];
    Frame F;
    F.lds = lds; F.tid = threadIdx.x; F.lane = F.tid & 63; F.wave = __builtin_amdgcn_readfirstlane(F.tid >> 6); F.G = gridDim.x; F.bid = blockIdx.x;
    F.in = (kargs_t)__builtin_amdgcn_kernarg_segment_ptr();
    F.out = (float*)F.in[N_IN]; F.ws = (unsigned char*)F.in[N_IN + 1];
    LAS unsigned char* llds = (LAS unsigned char*)lds;
    for (int u = F.tid; u < (LDS_BYTES - LDSCTL_OFF) / 4; u += NWAVES * 64) ((LAS unsigned*)(llds + LDSCTL_OFF))[u] = 0u;
    __syncthreads();
    XcdBarrier bar; bar.bar = (unsigned*)(F.ws + WS_CTL) + CW_BAR; bar.x = 0; bar.st = nullptr;
    const int ph_lo = args.ph_lo, ph_hi = args.ph_hi;
    if (ph_hi - ph_lo > 1) bar = xcd_barrier_post((unsigned*)(F.ws + WS_CTL) + CW_BAR, (volatile LAS unsigned*)(llds + MISC_OFF) + 8);
    for (int ph = ph_lo; ph < ph_hi; ++ph) {
        { kargs_t kp = (kargs_t)__builtin_amdgcn_kernarg_segment_ptr(); asm volatile("" : "+s"(kp)); F.in = kp; F.out = (float*)kp[N_IN]; F.ws = (unsigned char*)kp[N_IN + 1]; }
        { int tid = threadIdx.x; asm volatile("" : "+v"(tid)); int bid = blockIdx.x; asm volatile("" : "+s"(bid));
          F.tid = tid; F.lane = tid & 63; F.wave = __builtin_amdgcn_readfirstlane(tid >> 6); F.bid = bid; }
        unsigned char* ws = F.ws;
        bf16* WT = (bf16*)(ws + WS_W);
        if (ph == 0) p0_prologue(F);
        else if (ph == 1) norm_phase(F, 0, 0);
        else {
            const int l = (ph - 2) / 9, s = (ph - 2) % 9;
            if (s == 0) {
                pg8::Gemm g{(const bf16*)(ws + WS_XN), WT + WO_IN, M_TOK, NZ, 1024, nullptr, nullptr}; pg8::StaticOrder S; S.init(M_TOK, NZ, F.G, F.bid);
                pg8::EpiWin E{(bf16*)(ws + WS_Z), (bf16*)(ws + WS_G), F.out + O_CK + l * 32768, F.out + O_CV + l * 32768, (const float*)(ws + WS_ROPE)};
                pg8::gemm_phase<pg8::EpiWin, pg8::StaticOrder, true>(llds + RING_OFF, g, S, E, F.tid);
            } else if (s == 1) {
                mixer_phase(F, l);
            } else if (s == 2) {
                pg8::Gemm g{(const bf16*)(ws + WS_XN), WT + WO_GLU, M_TOK, 1024, 512, nullptr, nullptr}; pg8::StaticOrder S; S.init(M_TOK, 1024, F.G, F.bid);
                pg8::EpiGlu<0> E{(bf16*)(ws + WS_XN) + (size_t)M_TOK * 512, 512};
                pg8::gemm_phase<pg8::EpiGlu<0>, pg8::StaticOrder, true>(llds + RING_OFF, g, S, E, F.tid);
            } else if (s == 3) {
                pg8::Gemm g{(const bf16*)(ws + WS_XN) + (size_t)M_TOK * 512, WT + WO_BR, M_TOK, 1024, 512, (const bf16*)(ws + WS_Y), (const bf16*)(ws + WS_Y) + (size_t)M_TOK * 512};
                pg8::BranchOrder S; S.init(M_TOK, 1024, F.G, F.bid);
                pg8::EpiBranch E{(const bf16*)(ws + WS_G), (float*)(ws + WS_Z), (bf16*)(ws + WS_GS)};
                pg8::gemm_phase<pg8::EpiBranch, pg8::BranchOrder, true>(llds + RING_OFF, g, S, E, F.tid);
            } else if (s == 4) {
                pg8::Gemm g{(const bf16*)(ws + WS_GS), WT + WO_OUT, M_TOK, 1024, 1024, nullptr, nullptr}; pg8::StaticOrder S; S.init(M_TOK, 1024, F.G, F.bid);
                pg8::EpiF32 E{(float*)(ws + WS_Z), 1024};
                pg8::gemm_phase<pg8::EpiF32, pg8::StaticOrder, true>(llds + RING_OFF, g, S, E, F.tid);
            } else if (s == 5) {
                norm_phase(F, l, 1);
            } else if (s == 6) {
                pg8::Gemm g{(const bf16*)(ws + WS_XN), WT + WO_W1, M_TOK, FF2, 1024, nullptr, nullptr}; pg8::StaticOrder S; S.init(M_TOK, FF2, F.G, F.bid);
                pg8::EpiGlu<1> E{(bf16*)(ws + WS_G), FFH};
                pg8::gemm_phase<pg8::EpiGlu<1>, pg8::StaticOrder, true>(llds + RING_OFF, g, S, E, F.tid);
            } else if (s == 7) {
                pg8::Gemm g{(const bf16*)(ws + WS_G), WT + WO_W2, M_TOK, 1024, FFH, nullptr, nullptr}; pg8::StaticOrder S; S.init(M_TOK, 1024, F.G, F.bid);
                pg8::EpiF32 E{(float*)(ws + WS_Z), 1024};
                pg8::gemm_phase<pg8::EpiF32, pg8::StaticOrder, true>(llds + RING_OFF, g, S, E, F.tid);
            } else {
                norm_phase(F, l, 2);
                if (l == 0) convert_weights(F, 1);
            }
        }
        if (ph + 1 < ph_hi) xcd_barrier(bar);
    }
}

extern "C" void kernel_launch(void* const* d_in, const int* in_sizes, int n_in, void* d_out, int out_size, void* d_ws, size_t ws_size, hipStream_t stream) {
    static int grid = 0;
    if (grid == 0) {
        if (n_in != N_IN || out_size != (int)O_END || ws_size < WS_END) fprintf(stderr, "kernel_launch: unexpected shapes: n_in %d out %d ws %zu\n", n_in, out_size, ws_size);
        int dev = 0, cus = 0, per_cu = 0;
        if (hipGetDevice(&dev) != hipSuccess || hipDeviceGetAttribute(&cus, hipDeviceAttributeMultiprocessorCount, dev) != hipSuccess || cus <= 0) cus = 256;
        if (hipFuncSetAttribute((const void*)fwd_kernel, hipFuncAttributeMaxDynamicSharedMemorySize, LDS_BYTES) != hipSuccess) fprintf(stderr, "kernel_launch: hipFuncSetAttribute failed\n");
        if (hipOccupancyMaxActiveBlocksPerMultiprocessor(&per_cu, (const void*)fwd_kernel, NWAVES * 64, LDS_BYTES) != hipSuccess || per_cu < 1) fprintf(stderr, "kernel_launch: occupancy query reports %d workgroups per CU\n", per_cu);
        (void)hipGetLastError();
        grid = cus;
    }
    (void)hipMemsetAsync((char*)d_ws + WS_CTL, 0, CTL_ZERO_BYTES, stream);
    Args a{};
    for (int i = 0; i < N_IN; ++i) a.in[i] = (const float*)d_in[i];
    a.out = (float*)d_out; a.ws = (unsigned char*)d_ws;
#if MK_PER_PHASE
    for (int ph = 0; ph < N_PHASES; ++ph) { a.ph_lo = ph; a.ph_hi = ph + 1; hipLaunchKernelGGL(fwd_kernel, dim3(grid), dim3(NWAVES * 64), LDS_BYTES, stream, a); }
#else
    a.ph_lo = 0; a.ph_hi = N_PHASES;
    hipLaunchKernelGGL(fwd_kernel, dim3(grid), dim3(NWAVES * 64), LDS_BYTES, stream, a);
#endif
}
```

```cpp
#include <hip/hip_runtime.h>
#include <cstdio>
#include <cstdint>

#ifndef MK_PER_PHASE
#define MK_PER_PHASE 0
#endif

namespace pg8 {
#define PG8_LAS __attribute__((address_space(3)))
typedef unsigned short bf16_t;
typedef short bf16x8 __attribute__((ext_vector_type(8)));
typedef float f32x4 __attribute__((ext_vector_type(4)));
typedef float f32x2 __attribute__((ext_vector_type(2)));
typedef unsigned u32x4 __attribute__((ext_vector_type(4)));
typedef unsigned u32x2 __attribute__((ext_vector_type(2)));
constexpr int BM = 256, BK = 64, HALF = 128, HTB = HALF * BK * 2  , STAGE_BYTES = 8 * HTB, NXCD = 8, WGM = 8;

__host__ __device__ __forceinline__ int lds_byte(int r, int c) { const int st = (r >> 4) * 2 + (c >> 5), rr = r & 15, cc = c & 31, ob = rr * 64 + cc * 2; return st * 1024 + (ob ^ (((ob >> 9) & 1) << 5)); }
__host__ __device__ __forceinline__ void stage_rc(int b, int& R, int& C) { const int st = b / 1024, sb = b % 1024, swz = sb ^ (((sb >> 9) & 1) << 5); R = (st >> 1) * 16 + swz / 64; C = (st & 1) * 32 + (swz % 64) / 2; }
__host__ __device__ __forceinline__ int perm32(int rho) { const int n = rho >> 4, i = rho & 15; return 8 * (i >> 2) + 4 * n + (i & 3); }

struct Unit { int pm, pn, sel; };
struct Gemm { const bf16_t* A; const bf16_t* Bt; int M, N, K; const bf16_t* A1; const bf16_t* A2; };

struct StaticOrder {
    int nM, nN, nwg, G, c;
    __host__ __device__ void init(int M, int N, int G_, int c_) { nM = M / BM; nN = N / BM; nwg = nM * nN; G = G_; c = c_; }
    __host__ __device__ bool next(int i, Unit& u) const {
        const long L = (long)i * G + c; if (L >= nwg) return false;
        int wgid = (int)L; { const int q = nwg / NXCD, r = nwg % NXCD, xcd = wgid % NXCD, off = wgid / NXCD; wgid = (xcd < r ? xcd * (q + 1) : r * (q + 1) + (xcd - r) * q) + off; }
        const int nig = WGM * nN, gid = wgid / nig, fm = gid * WGM, gsz = (nM - fm) < WGM ? (nM - fm) : WGM;
        u.pm = fm + ((wgid % nig) % gsz); u.pn = (wgid % nig) / gsz; u.sel = 0; return true;
    }
    __device__ __forceinline__ const char* a_base(const Gemm& g, const Unit& u, size_t tstep) const { return (const char*)g.A + (size_t)u.pm * tstep; }
    __device__ __forceinline__ const char* b_base(const Gemm& g, const Unit& u, size_t tstep) const { return (const char*)g.Bt + (size_t)u.pn * tstep; }
};
struct BranchOrder {
    StaticOrder so;
    __host__ __device__ void init(int M, int N, int G_, int c_) { so.init(M, N, G_, c_); }
    __host__ __device__ bool next(int i, Unit& u) const { if (i >= 3) return false; if (!so.next(0, u)) return false; u.sel = i; return true; }
    __device__ __forceinline__ const char* a_base(const Gemm& g, const Unit& u, size_t tstep) const { const bf16_t* a = u.sel == 0 ? g.A : (u.sel == 1 ? g.A1 : g.A2); return (const char*)a + (size_t)u.pm * tstep; }
    __device__ __forceinline__ const char* b_base(const Gemm& g, const Unit& u, size_t tstep) const { return (const char*)g.Bt + (size_t)(u.sel * so.nN + u.pn) * tstep; }
};

__device__ __forceinline__ unsigned cvt_pk_bf16(float lo, float hi) { unsigned r; asm volatile("v_cvt_pk_bf16_f32 %0, %1, %2" : "=v"(r) : "v"(lo), "v"(hi)); return r; }
__device__ __forceinline__ float bf_lo(unsigned w) { return __builtin_bit_cast(float, w << 16); }
__device__ __forceinline__ float bf_hi(unsigned w) { return __builtin_bit_cast(float, w & 0xffff0000u); }
__device__ __forceinline__ float sigmoidf_(float x) { return 1.0f / (1.0f + __expf(-x)); }


struct EpiWin {
    static constexpr bool PERM = false, AFTER_DRAIN = false;
    bf16_t* Z; bf16_t* G; float* outk; float* outv; const float* rope;
    __device__ __forceinline__ void operator()(const f32x4 (&acc)[2][2][4][2], const Unit& u, int wr, int wc, int fr, int fq) const {
        const bool lat = u.pm >= 16;
        int rowb = u.pm * BM + wr * 64 + fr; asm volatile("" : "+v"(rowb));
#pragma unroll
        for (int bj = 0; bj < 2; ++bj) {
            const int c32 = u.pn * BM + bj * HALF + wc * 32;
            if (c32 >= 3072) {
#pragma unroll
                for (int ai = 0; ai < 2; ++ai)
#pragma unroll
                    for (int m = 0; m < 4; ++m) { bf16_t* gp = G + (size_t)(rowb + ai * HALF + m * 16) * 3072 + (c32 - 3072) + 4 * fq;
#pragma unroll
                        for (int n = 0; n < 2; ++n) { const f32x4 v = acc[ai][bj][m][n]; u32x2 w; w.x = cvt_pk_bf16(sigmoidf_(v[0]), sigmoidf_(v[1])); w.y = cvt_pk_bf16(sigmoidf_(v[2]), sigmoidf_(v[3])); *(u32x2*)(gp + 16 * n) = w; } }
            } else if (c32 >= 2848) {
            } else if (lat && c32 >= 2048 && c32 < 2688) {
                const float sc = c32 < 2560 ? 0.125f : 1.0f;
#pragma unroll
                for (int ai = 0; ai < 2; ++ai)
#pragma unroll
                    for (int m = 0; m < 4; ++m) { const int row = rowb + ai * HALF + m * 16, t = (row - 4096) & 1023, pos = (c32 & 32) ? (t & 63) : (t >> 6);
                        const f32x4* rp = (const f32x4*)(rope + (pos * 16 + 4 * fq) * 2); const f32x4 r0 = rp[0], r1 = rp[1];
                        const f32x4 x1 = acc[ai][bj][m][0] * sc, x2 = acc[ai][bj][m][1] * sc;
                        const f32x4 cs = (f32x4){r0[0], r0[2], r1[0], r1[2]}, sn = (f32x4){r0[1], r0[3], r1[1], r1[3]};
                        const f32x4 o1 = x1 * cs - x2 * sn, o2 = x1 * sn + x2 * cs;
                        bf16_t* zp = Z + (size_t)row * 2848 + c32 + 4 * fq;
                        u32x2 w; w.x = cvt_pk_bf16(o1[0], o1[1]); w.y = cvt_pk_bf16(o1[2], o1[3]); *(u32x2*)zp = w;
                        w.x = cvt_pk_bf16(o2[0], o2[1]); w.y = cvt_pk_bf16(o2[2], o2[3]); *(u32x2*)(zp + 16) = w; }
            } else {
                const float sc = ((c32 >= 512 && c32 < 768) || (c32 >= 2048 && c32 < 2560)) ? 0.125f : 1.0f;
                const bool kv32 = (!lat) && c32 >= 2560 && c32 < 2816;
                float* ob = c32 < 2688 ? outk : outv; const int cc = (c32 < 2688 ? c32 - 2560 : c32 - 2688) + 4 * fq;
#pragma unroll
                for (int ai = 0; ai < 2; ++ai)
#pragma unroll
                    for (int m = 0; m < 4; ++m) { const int row = rowb + ai * HALF + m * 16; bf16_t* zp = Z + (size_t)row * 2848 + c32 + 4 * fq;
#pragma unroll
                        for (int n = 0; n < 2; ++n) { const f32x4 v = acc[ai][bj][m][n] * sc; u32x2 w; w.x = cvt_pk_bf16(v[0], v[1]); w.y = cvt_pk_bf16(v[2], v[3]); *(u32x2*)(zp + 16 * n) = w;
                            if (kv32) *(f32x4*)(ob + (size_t)u.pm * 65536 + (size_t)(row & 255) * 128 + cc + 16 * n) = v; } }
            }
        }
    }
};
template <int MODE> struct EpiGlu {
    static constexpr bool PERM = true, AFTER_DRAIN = false;
    bf16_t* O; int ldc;
    __device__ __forceinline__ void operator()(const f32x4 (&acc)[2][2][4][2], const Unit& u, int wr, int wc, int fr, int fq) const {
        int row0 = u.pm * BM + wr * 64 + fr; asm volatile("" : "+v"(row0)); const int col0 = u.pn * HALF + wc * 32 + 8 * fq;
#pragma unroll
        for (int ai = 0; ai < 2; ++ai)
#pragma unroll
            for (int m = 0; m < 4; ++m) { bf16_t* rowp = O + (size_t)(row0 + ai * HALF + m * 16) * ldc + col0;
                f32x4 v[2];
#pragma unroll
                for (int n = 0; n < 2; ++n) { const f32x4 a = acc[ai][0][m][n], b = acc[ai][1][m][n];
#pragma unroll
                    for (int j = 0; j < 4; ++j) v[n][j] = MODE == 0 ? a[j] * sigmoidf_(b[j]) : a[j] * sigmoidf_(a[j]) * b[j]; }
                u32x4 w; w.x = cvt_pk_bf16(v[0][0], v[0][1]); w.y = cvt_pk_bf16(v[0][2], v[0][3]); w.z = cvt_pk_bf16(v[1][0], v[1][1]); w.w = cvt_pk_bf16(v[1][2], v[1][3]);
                *(u32x4*)rowp = w; }
    }
};
struct EpiBranch {
    static constexpr bool PERM = false, AFTER_DRAIN = false;
    const bf16_t* G; float* MF; bf16_t* MB;
    __device__ __forceinline__ void operator()(const f32x4 (&acc)[2][2][4][2], const Unit& u, int wr, int wc, int fr, int fq) const {
        int row0 = u.pm * BM + wr * 64 + fr; asm volatile("" : "+v"(row0)); const int col0 = u.pn * BM + wc * 32 + 4 * fq, sel = u.sel;
#pragma unroll
        for (int ai = 0; ai < 2; ++ai)
#pragma unroll
            for (int m = 0; m < 4; ++m) { const size_t row = (size_t)(row0 + ai * HALF + m * 16);
#pragma unroll
                for (int bj = 0; bj < 2; ++bj)
#pragma unroll
                    for (int n = 0; n < 2; ++n) { const int col = col0 + bj * HALF + n * 16;
                        const u32x2 gw = *(const u32x2*)(G + row * 3072 + sel * 1024 + col);
                        f32x4 v = acc[ai][bj][m][n] * (f32x4){bf_lo(gw.x), bf_hi(gw.x), bf_lo(gw.y), bf_hi(gw.y)};
                        if (sel > 0) v += *(const f32x4*)(MF + row * 1024 + col);
                        if (sel < 2) *(f32x4*)(MF + row * 1024 + col) = v;
                        else { u32x2 w; w.x = cvt_pk_bf16(v[0], v[1]); w.y = cvt_pk_bf16(v[2], v[3]); *(u32x2*)(MB + row * 1024 + col) = w; } } }
    }
};
struct EpiF32 {
    static constexpr bool PERM = false, AFTER_DRAIN = false;
    float* C; int ldc;
    __device__ __forceinline__ void operator()(const f32x4 (&acc)[2][2][4][2], const Unit& u, int wr, int wc, int fr, int fq) const {
        int row0 = u.pm * BM + wr * 64 + fr; asm volatile("" : "+v"(row0)); const int col0 = u.pn * BM + wc * 32 + 4 * fq;
#pragma unroll
        for (int ai = 0; ai < 2; ++ai)
#pragma unroll
            for (int m = 0; m < 4; ++m) { float* rowp = C + (size_t)(row0 + ai * HALF + m * 16) * ldc + col0;
#pragma unroll
                for (int bj = 0; bj < 2; ++bj)
#pragma unroll
                    for (int n = 0; n < 2; ++n) *(f32x4*)(rowp + bj * HALF + n * 16) = acc[ai][bj][m][n]; }
    }
};

template <class Epi, class Sched, bool ALIGN_EPI>
__device__ __forceinline__ void gemm_phase(PG8_LAS unsigned char* lds, const Gemm g, const Sched& S, const Epi& E, const int tid) {
    const int wid = __builtin_amdgcn_readfirstlane(tid >> 6), lane = tid & 63, wr = wid >> 2, wc = wid & 3, fr = lane & 15, fq = lane >> 4;
    const int K = g.K, nt = K / BK;
    unsigned voffA[2], voffB[2];
#pragma unroll
    for (int i = 0; i < 2; ++i) { int R, C; stage_rc(tid * 16 + i * 8192, R, C); const int Rb = Epi::PERM ? ((R & ~31) + perm32(R & 31)) : R;
        voffA[i] = (unsigned)(R * K + C) * 2u; voffB[i] = (unsigned)(Rb * K + C) * 2u; }
    const size_t kstep = (size_t)(BK * 2);
    const size_t hstep = (size_t)HALF * K * 2;
    const size_t tstep = 2 * hstep;
    const unsigned ldsw = (unsigned)wid * 1024u;
    const int aoff = lds_byte(wr * 64 + fr, fq * 8), boff = lds_byte(wc * 32 + fr, fq * 8);
#define PG8_SA(b, h) (((b) * 2 + (h)) * HTB)
#define PG8_SB(b, h) ((4 + (b) * 2 + (h)) * HTB)
#define PG8_STAGE(bufoff, gbase, voff) do { _Pragma("unroll") for (int _i = 0; _i < 2; ++_i) \
        __builtin_amdgcn_global_load_lds((const unsigned*)((const char*)(gbase) + (voff)[_i]), (PG8_LAS unsigned*)(lds + (bufoff) + ldsw + _i * 8192), 16, 0, 0); } while (0)
#define PG8_LDA(dst, b, h) do { _Pragma("unroll") for (int m = 0; m < 4; ++m) _Pragma("unroll") for (int k = 0; k < 2; ++k) dst[m][k] = *(const PG8_LAS bf16x8*)(lds + PG8_SA(b, h) + aoff + m * 2048 + k * 1024); } while (0)
#define PG8_LDB(dst, b, h) do { _Pragma("unroll") for (int n = 0; n < 2; ++n) _Pragma("unroll") for (int k = 0; k < 2; ++k) dst[n][k] = *(const PG8_LAS bf16x8*)(lds + PG8_SB(b, h) + boff + n * 2048 + k * 1024); } while (0)
#define PG8_MMA(ai, bj, At, Bt) do { __builtin_amdgcn_s_setprio(1); _Pragma("unroll") for (int m = 0; m < 4; ++m) _Pragma("unroll") for (int n = 0; n < 2; ++n) _Pragma("unroll") for (int k = 0; k < 2; ++k) \
        acc[ai][bj][m][n] = __builtin_amdgcn_mfma_f32_16x16x32_bf16(Bt[n][k], At[m][k], acc[ai][bj][m][n], 0, 0, 0); __builtin_amdgcn_s_setprio(0); } while (0)
#define PG8_WAIT_V(n) asm volatile("s_waitcnt vmcnt(" #n ")" ::: "memory")
#define PG8_WAIT_L(n) asm volatile("s_waitcnt lgkmcnt(" #n ")" ::: "memory")
#define PG8_BAR __builtin_amdgcn_s_barrier()
#define PG8_SCHED __builtin_amdgcn_sched_barrier(0)
    Unit cur, nxt; int ui = 0;
    if (!S.next(0, cur)) return;
    f32x4 acc[2][2][4][2];
#pragma unroll
    for (int a = 0; a < 2; ++a)
#pragma unroll
        for (int b = 0; b < 2; ++b)
#pragma unroll
            for (int m = 0; m < 4; ++m)
#pragma unroll
                for (int n = 0; n < 2; ++n) acc[a][b][m][n] = (f32x4){0.f, 0.f, 0.f, 0.f};
    bf16x8 At[4][2], B0[2][2], B1[2][2];
    const char* cA = S.a_base(g, cur, tstep); const char* cB = S.b_base(g, cur, tstep);
    PG8_STAGE(PG8_SB(0, 0), cB, voffB); PG8_STAGE(PG8_SB(0, 1), cB + hstep, voffB); PG8_STAGE(PG8_SA(0, 0), cA, voffA); PG8_STAGE(PG8_SA(0, 1), cA + hstep, voffA);
    if (wr == 1) PG8_BAR;
    PG8_WAIT_V(2); PG8_BAR;
    PG8_STAGE(PG8_SB(1, 0), cB + kstep, voffB); PG8_STAGE(PG8_SA(1, 0), cA + kstep, voffA); PG8_STAGE(PG8_SB(1, 1), cB + hstep + kstep, voffB);
    PG8_WAIT_V(6); PG8_BAR;
    for (;;) {
        const bool has_next = S.next(ui + 1, nxt);
        const char* nA = has_next ? S.a_base(g, nxt, tstep) : cA; const char* nB = has_next ? S.b_base(g, nxt, tstep) : cB;
        for (int t = 0; t < nt; t += 2) {
            const bool last = (t == nt - 2);
            const char* a1 = cA + (size_t)(t + 1) * kstep;
            const char* a2 = last ? nA : cA + (size_t)(t + 2) * kstep; const char* b2 = last ? nB : cB + (size_t)(t + 2) * kstep;
            const char* a3 = a2 + kstep; const char* b3 = b2 + kstep;
            PG8_LDB(B0, 0, 0); PG8_LDB(B1, 0, 1); PG8_SCHED; PG8_LDA(At, 0, 0); PG8_STAGE(PG8_SA(1, 1), a1 + hstep, voffA);
            PG8_WAIT_V(8); PG8_WAIT_L(0); PG8_BAR; PG8_MMA(0, 0, At, B0); PG8_MMA(0, 1, At, B1); PG8_BAR; PG8_SCHED;
            PG8_LDA(At, 0, 1); PG8_STAGE(PG8_SB(0, 0), b2, voffB); PG8_STAGE(PG8_SB(0, 1), b2 + hstep, voffB); PG8_STAGE(PG8_SA(0, 0), a2, voffA);
            PG8_WAIT_V(8); PG8_WAIT_L(0); PG8_BAR; PG8_MMA(1, 0, At, B0); PG8_MMA(1, 1, At, B1); PG8_BAR; PG8_SCHED;
            PG8_LDB(B0, 1, 0); PG8_LDB(B1, 1, 1); PG8_SCHED; PG8_LDA(At, 1, 0); PG8_STAGE(PG8_SA(0, 1), a2 + hstep, voffA);
            PG8_WAIT_V(8); PG8_WAIT_L(0); PG8_BAR; PG8_MMA(0, 0, At, B0); PG8_MMA(0, 1, At, B1); PG8_BAR; PG8_SCHED;
            PG8_LDA(At, 1, 1); PG8_STAGE(PG8_SB(1, 0), b3, voffB); PG8_STAGE(PG8_SB(1, 1), b3 + hstep, voffB); PG8_STAGE(PG8_SA(1, 0), a3, voffA);
            PG8_WAIT_V(8); PG8_WAIT_L(0); PG8_BAR; PG8_MMA(1, 0, At, B0); PG8_MMA(1, 1, At, B1); PG8_BAR; PG8_SCHED;
        }
        if constexpr (ALIGN_EPI) { if (wr == 0) PG8_BAR; }
        E(acc, cur, wr, wc, fr, fq);
        if (!has_next) break;
#pragma unroll
        for (int a = 0; a < 2; ++a)
#pragma unroll
            for (int b = 0; b < 2; ++b)
#pragma unroll
                for (int m = 0; m < 4; ++m)
#pragma unroll
                    for (int n = 0; n < 2; ++n) acc[a][b][m][n] = (f32x4){0.f, 0.f, 0.f, 0.f};
        cur = nxt; cA = nA; cB = nB; ++ui;
        if constexpr (ALIGN_EPI) { if (wr == 1) PG8_BAR; }
    }
    PG8_WAIT_V(0);
    if constexpr (!ALIGN_EPI) { if (wr == 0) PG8_BAR; }
    PG8_BAR;
#undef PG8_SA
#undef PG8_SB
#undef PG8_STAGE
#undef PG8_LDA
#undef PG8_LDB
#undef PG8_MMA
#undef PG8_WAIT_V
#undef PG8_WAIT_L
#undef PG8_BAR
#undef PG8_SCHED
}
}

constexpr int NWAVES = 8;
constexpr int DM = 1024, M_CTX = 4096, M_TOK = 12288, L_CTX = 256, L_LAT = 1024;
constexpr int ZP = 2848, GP = 3072, NZ = 6144, D_IN = 5920, FFH = 2816, FF2 = 5632;
constexpr float RMS_EPS = 1e-6f;
constexpr size_t O_Y = 0, O_CK = 12582912, O_CV = 13631488, O_S5 = 14680064, O_GLA = 14942208, O_END = 17039360;
enum { I_XP = 0, I_XS, I_CK, I_CV, I_SS5, I_SGLA, I_C, I_CCTX, I_WMOD, I_BMOD, I_NORMG, I_WIN, I_LRE, I_LIM, I_LSTEP, I_BRE, I_BIM, I_CRE, I_CIM, I_S5D, I_WGLU, I_WGK, I_BGK, I_GNG, I_SINK, I_WBR, I_WOUT, I_W1, I_W2, N_IN };

constexpr size_t MiB = 1u << 20;
constexpr size_t WS_CTL = 0, CTL_ZERO_BYTES = 64 * 1024;
constexpr size_t WS_MOD = 64 * 1024;
constexpr size_t WS_ROPE = 512 * 1024;
constexpr size_t WS_CKV = 1 * MiB;
constexpr size_t WS_W = 3 * MiB;
constexpr size_t WS_XN = 38 * MiB;
constexpr size_t WS_Z = 62 * MiB;
constexpr size_t WS_G = 129 * MiB;
constexpr size_t WS_GS = 201 * MiB;
constexpr size_t WS_Y = 225 * MiB;
constexpr size_t WS_END = 249 * MiB;
constexpr size_t WO_IN = 0, WO_GLU = 6291456, WO_BR = 6815744, WO_OUT = 8388608, WO_W1 = 9437184, WO_W2 = 15204352, WO_END = 18087936;
static_assert(WS_W + WO_END * 2 <= WS_XN && WS_XN + (size_t)M_TOK * 1024 * 2 <= WS_Z && WS_Z + (size_t)M_TOK * ZP * 2 <= WS_G && WS_G + (size_t)M_TOK * GP * 2 <= WS_GS && WS_GS + (size_t)M_TOK * 1024 * 2 <= WS_Y && WS_Y + (size_t)M_TOK * 1024 * 2 <= WS_END, "d_ws map");
constexpr int CW_BAR = 1024;

constexpr int RING_OFF = 0, RING_BYTES = 131072;
constexpr int LDSCTL_OFF = RING_BYTES, MISC_OFF = LDSCTL_OFF + 320;
constexpr int LDS_BYTES = 147456;
static_assert(MISC_OFF + 128 <= LDS_BYTES, "LDS map");

#define GAS __attribute__((address_space(1)))
#define LAS __attribute__((address_space(3)))
typedef unsigned short bf16;
typedef unsigned v4u __attribute__((ext_vector_type(4)));
typedef unsigned v2u __attribute__((ext_vector_type(2)));
typedef float f32x4 __attribute__((ext_vector_type(4)));
#define LDS_WAIT() asm volatile("s_waitcnt lgkmcnt(0)" ::: "memory")
__device__ __forceinline__ unsigned f2bf(float f) { unsigned u = __builtin_bit_cast(unsigned, f); return (u + 0x7fffu + ((u >> 16) & 1u)) >> 16; }
__device__ __forceinline__ unsigned pk2(float lo, float hi) { return f2bf(lo) | (f2bf(hi) << 16); }
__device__ __forceinline__ float bf2f(bf16 b) { return __builtin_bit_cast(float, ((unsigned)b) << 16); }
__device__ __forceinline__ float bflo(unsigned w) { return __builtin_bit_cast(float, w << 16); }
__device__ __forceinline__ float bfhi(unsigned w) { return __builtin_bit_cast(float, w & 0xffff0000u); }

#define XB_TMO      128
#define XB_XCNT(j)  (256  + 64 * (j))
#define XB_XSUB(j)  (1280 + 64 * (j))
#define XB_XGEN(j)  (2304 + 64 * (j))
#define XB_TOP      3328
#define XB_TOPGEN   3392
#define XCD_BAR_WORDS 3456
#define XB_SPIN_CAP (1u << 22)

__device__ __forceinline__ unsigned xb_ld(unsigned* p)              { return __hip_atomic_load(p, __ATOMIC_RELAXED, __HIP_MEMORY_SCOPE_AGENT); }
__device__ __forceinline__ unsigned xb_add(unsigned* p, unsigned v) { return __hip_atomic_fetch_add(p, v, __ATOMIC_RELAXED, __HIP_MEMORY_SCOPE_AGENT); }
__device__ __forceinline__ unsigned xb_xcc_id() { return (unsigned)__builtin_amdgcn_s_getreg((3 << 11) | 20) & 0xFu; }
#define XB_SPIN(cond, bar) do { unsigned _sp = 0; while (cond) { __builtin_amdgcn_s_sleep(1); \
    if ((++_sp & 255u) == 0u) { if (xb_ld(&(bar)[XB_TMO])) break; if (_sp > XB_SPIN_CAP) { atomicAdd(&(bar)[XB_TMO], 1u); break; } } } } while (0)

struct XcdBarrier {
    unsigned* bar; unsigned x;
    volatile LAS unsigned* st;
};

__device__ __forceinline__ XcdBarrier xcd_barrier_post(unsigned* bar, volatile LAS unsigned* st) {
    XcdBarrier b; b.bar = bar; b.x = xb_xcc_id(); b.st = st;
    if (threadIdx.x == 0) (void)xb_add(&bar[XB_XCNT(b.x)], 1u);
    return b;
}
__device__ __forceinline__ void xcd_barrier_complete(unsigned* bar, unsigned x, unsigned& nloc, unsigned& nx) {
    const unsigned G = gridDim.x * gridDim.y * gridDim.z;
    unsigned sum, cnt, mine, sp = 0u;
    for (;;) {
        sum = 0u; cnt = 0u; mine = 0u;
#pragma unroll
        for (unsigned j = 0; j < 16; ++j) { const unsigned c = xb_ld(&bar[XB_XCNT(j)]); sum += c; cnt += (c > 0u) ? 1u : 0u; mine = (j == x) ? c : mine; }
        if (sum == G) break;
        __builtin_amdgcn_s_sleep(1);
        if ((++sp & 255u) == 0u) { if (xb_ld(&bar[XB_TMO])) break; if (sp > XB_SPIN_CAP) { atomicAdd(&bar[XB_TMO], 1u); break; } }
    }
    nloc = mine > 0u ? mine : 1u; nx = cnt > 0u ? cnt : 1u;
}

__device__ __forceinline__ void xcd_barrier(const XcdBarrier& b) {
    asm volatile("s_waitcnt vmcnt(0)" ::: "memory");
    __syncthreads();
    if (threadIdx.x == 0) {
        unsigned* bar = b.bar;
        __builtin_amdgcn_s_waitcnt(0);
        unsigned nloc = b.st[0], nx = b.st[1];
        if (nloc == 0u) { xcd_barrier_complete(bar, b.x, nloc, nx); b.st[0] = nloc; b.st[1] = nx; }
        const unsigned old = xb_add(&bar[XB_XSUB(b.x)], 1u);
        const unsigned gen = old / nloc;
        if (old + 1u == (gen + 1u) * nloc) {
            __builtin_amdgcn_fence(__ATOMIC_RELEASE, "agent");
            asm volatile("s_waitcnt vmcnt(0)" ::: "memory");
            const unsigned og = xb_add(&bar[XB_TOP], 1u);
            const unsigned tg = og / nx;
            if (og + 1u == (tg + 1u) * nx) xb_add(&bar[XB_TOPGEN], 1u);
            else XB_SPIN(xb_ld(&bar[XB_TOPGEN]) == tg, bar);
            __builtin_amdgcn_fence(__ATOMIC_ACQUIRE, "agent");
            xb_add(&bar[XB_XGEN(b.x)], 1u);
            asm volatile("s_waitcnt vmcnt(0)" ::: "memory");
        } else {
            XB_SPIN(xb_ld(&bar[XB_XGEN(b.x)]) == gen, bar);
            __builtin_amdgcn_fence(__ATOMIC_ACQUIRE, "agent");
            asm volatile("s_waitcnt vmcnt(0)" ::: "memory");
        }
    }
    __syncthreads();
}


struct Args { const float* in[N_IN]; float* out; unsigned char* ws; int ph_lo, ph_hi; };
static_assert(sizeof(Args) == (N_IN + 2) * 8 + 8, "Args has no padding");
typedef const float* cfptr_t;
typedef const __attribute__((address_space(4))) cfptr_t* kargs_t;
struct Frame {
    unsigned char* lds;
    int tid, lane, wave, G, bid;
    kargs_t in; float* out; unsigned char* ws;
};
__device__ __forceinline__ float wave_sum(float v) {
#pragma unroll
    for (int o = 1; o < 64; o <<= 1) v += __shfl_xor(v, o);
    return v;
}
__device__ __forceinline__ const float* xin_row(const Frame& F, int row) { return row < M_CTX ? F.in[I_XP] + (size_t)row * DM : F.in[I_XS] + (size_t)(row - M_CTX) * DM; }
__device__ __forceinline__ int path_of(int row) { return row < M_CTX ? 0 : 1 + ((row - M_CTX) >> 10); }

__device__ __forceinline__ int map_row(int mapk, int n0) {
    if (mapk == 0) return n0;
    if (mapk == 1) { if (n0 < 2048) return n0; if (n0 < 2080) return 2816 + (n0 - 2048); if (n0 < 2848) return 2048 + (n0 - 2080); return 3072 + (n0 - 2848); }
    const int half = mapk == 2 ? 512 : 2816;
    if (n0 < half) return (n0 / 128) * 256 + (n0 % 128);
    const int s = n0 - half; return (s / 128) * 256 + 128 + (s % 128);
}
__device__ __forceinline__ void p0_transpose_item(const float* W, int K, int N, bf16* WT, int mapk, float* scr, int item, int lane) {
    const int nblk = N / 32, kb = item / nblk, nb = item % nblk, k0 = 64 * kb, n0 = 32 * nb, d0 = map_row(mapk, n0);
#pragma unroll 8
    for (int i = 0; i < 32; ++i) { const int kk = 2 * i + (lane >> 5); scr[kk * 33 + (lane & 31)] = W[(size_t)(k0 + kk) * N + n0 + (lane & 31)]; }
    LDS_WAIT(); asm volatile("" ::: "memory");
    const int c = lane & 7;
#pragma unroll
    for (int j = 0; j < 4; ++j) { const int n = (lane >> 3) + 8 * j; const float* s = scr + (8 * c) * 33 + n;
        v4u o; o.x = pk2(s[0 * 33], s[1 * 33]); o.y = pk2(s[2 * 33], s[3 * 33]); o.z = pk2(s[4 * 33], s[5 * 33]); o.w = pk2(s[6 * 33], s[7 * 33]);
        *(v4u*)(WT + (size_t)(d0 + n) * K + k0 + 8 * c) = o; }
    LDS_WAIT(); asm volatile("" ::: "memory");
}
__device__ __forceinline__ void convert_weights(const Frame& F, int l) {
    float* scr = (float*)(F.lds + RING_OFF + F.wave * 16384);
    bf16* WT = (bf16*)(F.ws + WS_W);
    const int gw = F.bid * NWAVES + F.wave, NGW = F.G * NWAVES;
    constexpr int I0 = 16 * 185, I1 = 8 * 32, I2 = 3 * 8 * 32, I3 = 16 * 32, I4 = 16 * 176, I5 = 44 * 32;
    for (int it = gw; it < I0 + I1 + I2 + I3 + I4 + I5; it += NGW) {
        int r = it;
        if (r < I0) { p0_transpose_item(F.in[I_WIN] + (size_t)l * 1024 * D_IN, 1024, D_IN, WT + WO_IN, 1, scr, r, F.lane); continue; } r -= I0;
        if (r < I1) { p0_transpose_item(F.in[I_WGLU] + (size_t)l * 512 * 1024, 512, 1024, WT + WO_GLU, 2, scr, r, F.lane); continue; } r -= I1;
        if (r < I2) { const int n = r / 256; p0_transpose_item(F.in[I_WBR] + (size_t)(l * 3 + n) * 512 * 1024, 512, 1024, WT + WO_BR + (size_t)n * 1024 * 512, 0, scr, r % 256, F.lane); continue; } r -= I2;
        if (r < I3) { p0_transpose_item(F.in[I_WOUT] + (size_t)l * 1024 * 1024, 1024, 1024, WT + WO_OUT, 0, scr, r, F.lane); continue; } r -= I3;
        if (r < I4) { p0_transpose_item(F.in[I_W1] + (size_t)l * 1024 * FF2, 1024, FF2, WT + WO_W1, 3, scr, r, F.lane); continue; } r -= I4;
        p0_transpose_item(F.in[I_W2] + (size_t)l * FFH * 1024, FFH, 1024, WT + WO_W2, 0, scr, r, F.lane);
    }
}
__device__ __forceinline__ void mod_items(const Frame& F) {
    float* SC = (float*)(F.lds);
    float* RED = (float*)(F.lds + 40960);
    float* MOD = (float*)(F.ws + WS_MOD);
    if (F.bid >= 192) return;
    for (int i = F.tid; i < 9 * 1024; i += NWAVES * 64) { const float c = i < 1024 ? F.in[I_CCTX][i] : F.in[I_C][i - 1024]; SC[i] = c / (1.0f + __expf(-c)); }
    __syncthreads();
    const int item = F.bid, l = item / 96, col = (item % 96) * 64 + F.lane;
    const float* wm = F.in[I_WMOD] + ((size_t)l * 1024 + F.wave * 128) * 6144 + col;
    float acc[9];
#pragma unroll
    for (int r = 0; r < 9; ++r) acc[r] = 0.f;
#pragma unroll 8
    for (int kk = 0; kk < 128; ++kk) { const float wv = wm[(size_t)kk * 6144]; const int k = F.wave * 128 + kk;
#pragma unroll
        for (int r = 0; r < 9; ++r) acc[r] += SC[r * 1024 + k] * wv; }
#pragma unroll
    for (int r = 0; r < 9; ++r) RED[(F.wave * 9 + r) * 64 + F.lane] = acc[r];
    __syncthreads();
    for (int o = F.tid; o < 576; o += NWAVES * 64) { const int r = o >> 6, ln = o & 63; float s = F.in[I_BMOD][l * 6144 + (item % 96) * 64 + ln];
#pragma unroll
        for (int w = 0; w < 8; ++w) s += RED[(w * 9 + r) * 64 + ln];
        MOD[(size_t)(l * 9 + r) * 6144 + (item % 96) * 64 + ln] = s; }
    __syncthreads();
}
__device__ __forceinline__ void p0_prologue(const Frame& F) {
    mod_items(F);
    const int gt = F.bid * (NWAVES * 64) + F.tid, NGT = F.G * NWAVES * 64;
    if (gt < 1024) { const int pos = gt >> 4, q = gt & 15; const float inv = powf(10000.0f, -(float)q / 16.0f), ang = (float)pos * inv; float* rp = (float*)(F.ws + WS_ROPE); rp[gt * 2] = cosf(ang); rp[gt * 2 + 1] = sinf(ang); }
    { bf16* ck = (bf16*)(F.ws + WS_CKV); bf16* cv = ck + 524288;
      for (int i = gt; i < 524288; i += NGT) { const int c = i & 127, j = (i >> 7) & 255, b = (i >> 15) & 7, l = i >> 18; const size_t s = ((size_t)((b * 2 + l) * 256 + j)) * 128 + c;
          ck[i] = (bf16)f2bf(F.in[I_CK][s]); cv[i] = (bf16)f2bf(F.in[I_CV][s]); } }
    convert_weights(F, 0);
}

__device__ __forceinline__ void norm_phase(const Frame& F, int l, int mode) {
    const int gw = F.bid * NWAVES + F.wave, NGW = F.G * NWAVES;
    const float* MOD = (const float*)(F.ws + WS_MOD);
    const float* RAW = (const float*)(F.ws + WS_Z);
    bf16* XN = (bf16*)(F.ws + WS_XN);
    float* X = F.out + O_Y;
    for (int row = gw; row < M_TOK; row += NGW) {
        const int pb = path_of(row);
        const float* modl = MOD + (size_t)(l * 9 + pb) * 6144;
        const float* ng = F.in[I_NORMG] + l * 4096;
        const float* xs = (mode == 2 || l == 1) ? X + (size_t)row * DM : xin_row(F, row);
        f32x4 xv[4];
#pragma unroll
        for (int j = 0; j < 4; ++j) xv[j] = ((const f32x4*)xs)[F.lane + 64 * j];
        if (mode >= 1) {
            f32x4 rv[4]; float ss = 0.f;
#pragma unroll
            for (int j = 0; j < 4; ++j) { rv[j] = ((const f32x4*)(RAW + (size_t)row * DM))[F.lane + 64 * j]; ss += rv[j].x * rv[j].x + rv[j].y * rv[j].y + rv[j].z * rv[j].z + rv[j].w * rv[j].w; }
            const float rstd = 1.0f / sqrtf(wave_sum(ss) * (1.0f / DM) + RMS_EPS);
            const float* gate = modl + (mode == 1 ? 2048 : 5120); const float* nga = ng + (mode == 1 ? 1024 : 3072);
#pragma unroll
            for (int j = 0; j < 4; ++j) { const f32x4 gv = ((const f32x4*)gate)[F.lane + 64 * j], nv = ((const f32x4*)nga)[F.lane + 64 * j]; xv[j] = xv[j] + gv * (rv[j] * rstd * nv); ((f32x4*)(X + (size_t)row * DM))[F.lane + 64 * j] = xv[j]; }
        }
        if (mode == 2 && l == 1) continue;
        const int ln = mode == 2 ? l + 1 : l;
        const float* modn = MOD + (size_t)(ln * 9 + pb) * 6144;
        const float* ngb = F.in[I_NORMG] + ln * 4096 + (mode == 1 ? 2048 : 0);
        const float* sc = modn + (mode == 1 ? 4096 : 1024); const float* sh = modn + (mode == 1 ? 3072 : 0);
        float ss = 0.f;
#pragma unroll
        for (int j = 0; j < 4; ++j) ss += xv[j].x * xv[j].x + xv[j].y * xv[j].y + xv[j].z * xv[j].z + xv[j].w * xv[j].w;
        const float rstd = 1.0f / sqrtf(wave_sum(ss) * (1.0f / DM) + RMS_EPS);
#pragma unroll
        for (int j = 0; j < 4; ++j) { const f32x4 nv = ((const f32x4*)ngb)[F.lane + 64 * j], sv = ((const f32x4*)sc)[F.lane + 64 * j], hv = ((const f32x4*)sh)[F.lane + 64 * j];
            const f32x4 o = xv[j] * rstd * nv * (sv + 1.0f) + hv; v2u w; w.x = pk2(o.x, o.y); w.y = pk2(o.z, o.w); ((v2u*)(XN + (size_t)row * DM))[F.lane + 64 * j] = w; }
    }
}

__device__ __forceinline__ float gelu_tanh(float x) { const float u = 0.7978845608028654f * (x + 0.044715f * x * x * x); return 0.5f * x * (1.0f + tanhf(u)); }
typedef float f32x16 __attribute__((ext_vector_type(16)));
typedef short bf16x8 __attribute__((ext_vector_type(8)));
typedef short bf16x4 __attribute__((ext_vector_type(4)));
#define MFMA32(a, b, c) __builtin_amdgcn_mfma_f32_32x32x16_bf16((a), (b), (c), 0, 0, 0)
__device__ __forceinline__ unsigned cvtpk(float lo, float hi) { unsigned r; asm("v_cvt_pk_bf16_f32 %0, %1, %2" : "=v"(r) : "v"(lo), "v"(hi)); return r; }
__device__ __forceinline__ int crow(int r, int hh) { return (r & 3) + 8 * (r >> 2) + 4 * hh; }
__device__ __forceinline__ bf16x8 acc_frag(const f32x16& a, int s) {
    v4u w; w.x = cvtpk(a[8 * s + 0], a[8 * s + 1]); w.y = cvtpk(a[8 * s + 2], a[8 * s + 3]); w.z = cvtpk(a[8 * s + 4], a[8 * s + 5]); w.w = cvtpk(a[8 * s + 6], a[8 * s + 7]);
    return __builtin_bit_cast(bf16x8, w);
}
__device__ __forceinline__ bf16x8 cat4(bf16x4 a, bf16x4 b) { return __builtin_shufflevector(a, b, 0, 1, 2, 3, 4, 5, 6, 7); }

typedef float f32x4m __attribute__((ext_vector_type(4)));
constexpr int S5_HS = 272, S5_WB = 33 * S5_HS;
__device__ __forceinline__ float gelu_fast(float x) { const float u = 0.7978845608028654f * (x + 0.044715f * x * x * x); const float e = __expf(2.0f * u); return 0.5f * x * (2.0f - 2.0f / (1.0f + e)); }
__device__ __forceinline__ void s5_item(const Frame& F, int l, int item) {
    const int w = F.wave, lane = F.lane, hh = lane >> 5, c31 = lane & 31, l15 = lane & 15, l4 = lane >> 4, pair = item * 4 + (w >> 1), d = w & 1;
    const bool lat = pair < 256; const int pp = lat ? pair : pair - 256, b = pp >> 5, g = pp & 31;
    const int L = lat ? L_LAT : L_CTX, row0 = lat ? M_CTX + b * L_LAT : b * L_CTX, nch = L >> 5;
    const bf16* Z = (const bf16*)(F.ws + WS_Z); bf16* SS = (bf16*)(F.ws + WS_XN);
    unsigned char* Hb = F.lds + w * S5_WB;
    float ar[2], ai[2]; bf16x8 bfr[4], cfr[4]; float hr[2], hi[2];
#pragma unroll
    for (int q = 0; q < 2; ++q) {
        const int pidx = ((l * 2 + d) * 32 + g) * 64 + 32 * q + c31;
        const float lre = F.in[I_LRE][pidx], lim = F.in[I_LIM][pidx], dt = expf(F.in[I_LSTEP][pidx]);
        const float mag = expf(lre * dt); float sn, cs; sincosf(lim * dt, &sn, &cs);
        ar[q] = mag * cs; ai[q] = mag * sn; const float nr = ar[q] - 1.0f, ni = ai[q], den = lre * lre + lim * lim;
        const float fr = (nr * lre + ni * lim) / den, fi = (ni * lre - nr * lim) / den;
        const f32x4* brp = (const f32x4*)(F.in[I_BRE] + (size_t)pidx * 16 + 8 * hh); const f32x4* bip = (const f32x4*)(F.in[I_BIM] + (size_t)pidx * 16 + 8 * hh);
        const f32x4 br0 = brp[0], br1 = brp[1], bi0 = bip[0], bi1 = bip[1];
        v4u wr_, wi_;
        wr_.x = cvtpk(fr * br0[0] - fi * bi0[0], fr * br0[1] - fi * bi0[1]); wr_.y = cvtpk(fr * br0[2] - fi * bi0[2], fr * br0[3] - fi * bi0[3]); wr_.z = cvtpk(fr * br1[0] - fi * bi1[0], fr * br1[1] - fi * bi1[1]); wr_.w = cvtpk(fr * br1[2] - fi * bi1[2], fr * br1[3] - fi * bi1[3]);
        wi_.x = cvtpk(fr * bi0[0] + fi * br0[0], fr * bi0[1] + fi * br0[1]); wi_.y = cvtpk(fr * bi0[2] + fi * br0[2], fr * bi0[3] + fi * br0[3]); wi_.z = cvtpk(fr * bi1[0] + fi * br1[0], fr * bi1[1] + fi * br1[1]); wi_.w = cvtpk(fr * bi1[2] + fi * br1[2], fr * bi1[3] + fi * br1[3]);
        bfr[q] = __builtin_bit_cast(bf16x8, wr_); bfr[2 + q] = __builtin_bit_cast(bf16x8, wi_);
        hr[q] = 0.f; hi[q] = 0.f;
        if (lat) { const size_t si = ((size_t)((((b * 2 + l) * 2 + d) * 32 + g) * 64 + 32 * q + c31)) * 2; hr[q] = F.in[I_SS5][si]; hi[q] = F.in[I_SS5][si + 1]; }
    }
#pragma unroll
    for (int kk = 0; kk < 4; ++kk) {
        const size_t cb = ((size_t)(((l * 2 + d) * 32 + g) * 16 + l15)) * 64 + kk * 16 + 4 * l4;
        const f32x4 cr = *(const f32x4*)(F.in[I_CRE] + cb), ci = *(const f32x4*)(F.in[I_CIM] + cb);
        v4u wc_; wc_.x = cvtpk(cr[0], -ci[0]); wc_.y = cvtpk(cr[1], -ci[1]); wc_.z = cvtpk(cr[2], -ci[2]); wc_.w = cvtpk(cr[3], -ci[3]);
        cfr[kk] = __builtin_bit_cast(bf16x8, wc_);
    }
    const float dsk = F.in[I_S5D][l * 512 + g * 16 + l15];
    asm volatile("" ::: "memory");
    const f32x16 zero16 = {0.f, 0.f, 0.f, 0.f, 0.f, 0.f, 0.f, 0.f, 0.f, 0.f, 0.f, 0.f, 0.f, 0.f, 0.f, 0.f};
    bf16x8 unext = *(const bf16x8*)(Z + (size_t)(row0 + (d ? L - 1 - c31 : c31)) * ZP + g * 16 + 8 * hh);
    for (int c0 = 0; c0 < nch; ++c0) {
        int c = c0; asm volatile("" : "+s"(c));
        const bf16x8 uf = unext;
        if (c + 1 < nch) { const int tau = 32 * (c + 1) + c31; unext = *(const bf16x8*)(Z + (size_t)(row0 + (d ? L - 1 - tau : tau)) * ZP + g * 16 + 8 * hh); }
        const f32x16 bur0 = MFMA32(uf, bfr[0], zero16), bur1 = MFMA32(uf, bfr[1], zero16), bui0 = MFMA32(uf, bfr[2], zero16), bui1 = MFMA32(uf, bfr[3], zero16);
#pragma unroll
        for (int g8 = 0; g8 < 8; ++g8) {
            float r0 = hr[0], i0 = hi[0], r1 = hr[1], i1 = hi[1];
            unsigned char* hrow = (hh == (g8 & 1)) ? Hb + (4 * g8) * S5_HS : Hb + 32 * S5_HS - 0 * S5_HS;
            const int rstep = (hh == (g8 & 1)) ? S5_HS : 0;
#pragma unroll
            for (int i = 0; i < 4; ++i) { const int r = 4 * (g8 >> 1) + i;
                const float n0 = ar[0] * r0 - ai[0] * i0 + bur0[r], m0 = ar[0] * i0 + ai[0] * r0 + bui0[r]; r0 = n0; i0 = m0;
                const float n1 = ar[1] * r1 - ai[1] * i1 + bur1[r], m1 = ar[1] * i1 + ai[1] * r1 + bui1[r]; r1 = n1; i1 = m1;
                *(unsigned*)(hrow + i * rstep + c31 * 4) = cvtpk(r0, i0); *(unsigned*)(hrow + i * rstep + (32 + c31) * 4) = cvtpk(r1, i1); }
            { auto t = __builtin_amdgcn_permlane32_swap(__float_as_uint(r0), __float_as_uint(r0), false, false); hr[0] = __uint_as_float(t[g8 & 1]); }
            { auto t = __builtin_amdgcn_permlane32_swap(__float_as_uint(i0), __float_as_uint(i0), false, false); hi[0] = __uint_as_float(t[g8 & 1]); }
            { auto t = __builtin_amdgcn_permlane32_swap(__float_as_uint(r1), __float_as_uint(r1), false, false); hr[1] = __uint_as_float(t[g8 & 1]); }
            { auto t = __builtin_amdgcn_permlane32_swap(__float_as_uint(i1), __float_as_uint(i1), false, false); hi[1] = __uint_as_float(t[g8 & 1]); }
        }
        f32x4m y0 = {0.f, 0.f, 0.f, 0.f}, y1 = {0.f, 0.f, 0.f, 0.f};
#pragma unroll
        for (int kk = 0; kk < 4; ++kk) {
            y0 = __builtin_amdgcn_mfma_f32_16x16x32_bf16(*(const bf16x8*)(Hb + l15 * S5_HS + (kk * 32 + 8 * l4) * 2), cfr[kk], y0, 0, 0, 0);
            y1 = __builtin_amdgcn_mfma_f32_16x16x32_bf16(*(const bf16x8*)(Hb + (16 + l15) * S5_HS + (kk * 32 + 8 * l4) * 2), cfr[kk], y1, 0, 0, 0);
        }
        const bool fin = c >= (nch >> 1);
#pragma unroll
        for (int mt = 0; mt < 2; ++mt)
#pragma unroll
            for (int r = 0; r < 4; ++r) { const int tau = 32 * c + 16 * mt + 4 * l4 + r, t = d ? L - 1 - tau : tau; const size_t row = (size_t)(row0 + t);
                bf16* sp = SS + row * 512 + g * 16 + l15; float y = mt ? y1[r] : y0[r];
                if (fin) y = gelu_fast(y + bf2f(*sp) + dsk * bf2f(Z[row * ZP + g * 16 + l15]));
                *sp = (bf16)f2bf(y); }
        if (c == (nch >> 1) - 1) __syncthreads();
    }
    if (!lat && hh == 0) {
#pragma unroll
        for (int q = 0; q < 2; ++q) { float* so = F.out + O_S5 + ((size_t)((((b * 2 + l) * 2 + d) * 32 + g) * 64 + 32 * q + c31)) * 2; so[0] = hr[q]; so[1] = hi[q]; }
    }
    __syncthreads();
}
constexpr int GL_QT = 0, GL_KT = 4608, GL_KTT = 9216, GL_VT = 14336, GL_EB = 24576, GL_BUF = 24832, GL_DIR = 2 * GL_BUF;
__device__ __forceinline__ void gla_item(const Frame& F, int l, int item) {
    const bool lat = item < 32; const int ii = lat ? item : item - 32, b = ii >> 2, h = ii & 3;
    const int L = lat ? L_LAT : L_CTX, row0 = lat ? M_CTX + b * L_LAT : b * L_CTX, nch = L >> 5;
    const int d = F.wave >> 2, sl = F.wave & 3, lane = F.lane, hh = lane >> 5, c31 = lane & 31;
    const bf16* Z = (const bf16*)(F.ws + WS_Z); bf16* GS = (bf16*)(F.ws + WS_GS); bf16* YB = (bf16*)(F.ws + WS_Y);
    unsigned char* ldd = F.lds + d * GL_DIR;
    const int dka = sl * 16 + (lane & 15), tg = lane >> 4;
    float wg[16];
#pragma unroll
    for (int r = 0; r < 16; ++r) wg[r] = F.in[I_WGK][((size_t)((l * 2 + d) * 16 + r)) * 256 + h * 64 + dka];
    const float bg = F.in[I_BGK][(l * 2 + d) * 256 + h * 64 + dka];
    const int dt = sl * 64 + lane;
    f32x16 S0, S1;
#pragma unroll
    for (int r = 0; r < 16; ++r) {
        const size_t sb = ((size_t)((((b * 2 + l) * 2 + d) * 4 + h) * 64)) * 128 + sl * 32 + c31;
        const float* sp = F.in[I_SGLA] + (lat ? sb : (size_t)0); const float lm = lat ? 1.f : 0.f;
        S0[r] = sp[(size_t)crow(r, hh) * 128] * lm; S1[r] = sp[(size_t)(32 + crow(r, hh)) * 128] * lm; }
    asm volatile("" ::: "memory");
#define GLA_STEP_A(c) do { unsigned char* bufp = ldd + ((c) & 1) * GL_BUF; \
        float gk[8]; unsigned qk[8]; \
        _Pragma("unroll") for (int e = 0; e < 8; ++e) { asm volatile("" ::: "memory"); const int rho = 8 * tg + e, tau = 32 * (c) + rho, t = d ? L - 1 - tau : tau; const bf16* zr = Z + (size_t)(row0 + t) * ZP; \
            const v4u a0 = *(const v4u*)(zr + 2816 + d * 16), a1 = *(const v4u*)(zr + 2824 + d * 16); \
            float x = bg + wg[0] * bflo(a0.x) + wg[1] * bfhi(a0.x) + wg[2] * bflo(a0.y) + wg[3] * bfhi(a0.y) + wg[4] * bflo(a0.z) + wg[5] * bfhi(a0.z) + wg[6] * bflo(a0.w) + wg[7] * bfhi(a0.w); \
            x += wg[8] * bflo(a1.x) + wg[9] * bfhi(a1.x) + wg[10] * bflo(a1.y) + wg[11] * bfhi(a1.y) + wg[12] * bflo(a1.z) + wg[13] * bfhi(a1.z) + wg[14] * bflo(a1.w) + wg[15] * bfhi(a1.w); \
            gk[e] = (fminf(x, 0.f) - __logf(1.0f + __expf(-fabsf(x)))) * 0.0625f; \
            qk[e] = (unsigned)zr[512 + h * 64 + dka] | ((unsigned)zr[768 + h * 64 + dka] << 16); } \
        _Pragma("unroll") for (int e = 1; e < 8; ++e) gk[e] += gk[e - 1]; \
        { const float tot = gk[7]; float p1 = __shfl_up(tot, 16), p2 = __shfl_up(tot, 32), p3 = __shfl_up(tot, 48); const float pre = (tg >= 1 ? p1 : 0.f) + (tg >= 2 ? p2 : 0.f) + (tg >= 3 ? p3 : 0.f); \
          _Pragma("unroll") for (int e = 0; e < 8; ++e) gk[e] += pre; } \
        unsigned kt8[4]; \
        _Pragma("unroll") for (int e = 0; e < 8; ++e) { const int rho = 8 * tg + e; const float ep = __expf(gk[e]), em = __expf(-gk[e]); const float qv = bflo(qk[e]) * ep, kv = bfhi(qk[e]) * em; \
            const unsigned kb = f2bf(kv); ((bf16*)(bufp + GL_QT))[rho * 72 + dka] = (bf16)f2bf(qv); ((bf16*)(bufp + GL_KT))[rho * 72 + dka] = (bf16)kb; \
            if (e & 1) kt8[e >> 1] |= kb << 16; else kt8[e >> 1] = kb; } \
        *(v4u*)(bufp + GL_KTT + dka * 80 + tg * 16) = (v4u){kt8[0], kt8[1], kt8[2], kt8[3]}; \
        if (tg == 3) ((float*)(bufp + GL_EB))[dka] = __expf(gk[7]); \
        _Pragma("unroll") for (int k2 = 0; k2 < 2; ++k2) { const int sidx = dt + 256 * k2, rho = sidx >> 4, sg = sidx & 15, tau = 32 * (c) + rho, t = d ? L - 1 - tau : tau; \
            const v4u vv = *(const v4u*)(Z + (size_t)(row0 + t) * ZP + 1024 + h * 128 + sg * 8); bf16* vt = (bf16*)(bufp + GL_VT) + (sg * 8) * 40 + rho; \
            vt[0] = (bf16)(vv.x & 0xffff); vt[40] = (bf16)(vv.x >> 16); vt[80] = (bf16)(vv.y & 0xffff); vt[120] = (bf16)(vv.y >> 16); vt[160] = (bf16)(vv.z & 0xffff); vt[200] = (bf16)(vv.z >> 16); vt[240] = (bf16)(vv.w & 0xffff); vt[280] = (bf16)(vv.w >> 16); } \
    } while (0)
    { int cz = 0; asm volatile("" : "+s"(cz)); GLA_STEP_A(cz); }
    __syncthreads();
    for (int c0 = 0; c0 < nch; ++c0) {
        int c = c0; asm volatile("" : "+s"(c));
        const unsigned char* bufp = ldd + (c & 1) * GL_BUF;
        const bf16* QT = (const bf16*)(bufp + GL_QT); const bf16* KT = (const bf16*)(bufp + GL_KT); const bf16* KTT = (const bf16*)(bufp + GL_KTT); const bf16* VT = (const bf16*)(bufp + GL_VT); const float* EB = (const float*)(bufp + GL_EB);
        f32x16 at = {0.f, 0.f, 0.f, 0.f, 0.f, 0.f, 0.f, 0.f, 0.f, 0.f, 0.f, 0.f, 0.f, 0.f, 0.f, 0.f};
#pragma unroll
        for (int s = 0; s < 4; ++s) at = MFMA32(*(const bf16x8*)(KT + c31 * 72 + 16 * s + 8 * hh), *(const bf16x8*)(QT + c31 * 72 + 16 * s + 8 * hh), at);
#pragma unroll
        for (int r = 0; r < 16; ++r) if (crow(r, hh) > c31) at[r] = 0.f;
        asm volatile("" ::: "memory");
        f32x16 o = {0.f, 0.f, 0.f, 0.f, 0.f, 0.f, 0.f, 0.f, 0.f, 0.f, 0.f, 0.f, 0.f, 0.f, 0.f, 0.f};
#pragma unroll
        for (int s = 0; s < 2; ++s) {
            o = MFMA32(cat4(*(const bf16x4*)(QT + c31 * 72 + 16 * s + 4 * hh), *(const bf16x4*)(QT + c31 * 72 + 16 * s + 8 + 4 * hh)), acc_frag(S0, s), o);
            o = MFMA32(cat4(*(const bf16x4*)(QT + c31 * 72 + 32 + 16 * s + 4 * hh), *(const bf16x4*)(QT + c31 * 72 + 32 + 16 * s + 8 + 4 * hh)), acc_frag(S1, s), o);
        }
        const bf16* vtr = VT + (sl * 32 + c31) * 40;
#pragma unroll
        for (int s = 0; s < 2; ++s) o = MFMA32(acc_frag(at, s), cat4(*(const bf16x4*)(vtr + 16 * s + 4 * hh), *(const bf16x4*)(vtr + 16 * s + 8 + 4 * hh)), o);
#pragma unroll
        for (int r = 0; r < 16; ++r) { const int tau = 32 * c + crow(r, hh), t = d ? L - 1 - tau : tau; GS[(size_t)d * M_TOK * 512 + (size_t)(row0 + t) * 512 + h * 128 + sl * 32 + c31] = (bf16)f2bf(o[r]); }
        asm volatile("" ::: "memory");
#pragma unroll
        for (int s = 0; s < 2; ++s) { const bf16x8 vb = *(const bf16x8*)(vtr + 16 * s + 8 * hh);
            S0 = MFMA32(*(const bf16x8*)(KTT + c31 * 40 + 16 * s + 8 * hh), vb, S0); S1 = MFMA32(*(const bf16x8*)(KTT + (32 + c31) * 40 + 16 * s + 8 * hh), vb, S1); }
#pragma unroll
        for (int r = 0; r < 16; ++r) { S0[r] *= EB[crow(r, hh)]; S1[r] *= EB[32 + crow(r, hh)]; }
        asm volatile("" ::: "memory");
        if (c + 1 < nch) GLA_STEP_A(c + 1);
        __syncthreads();
    }
#undef GLA_STEP_A
    if (!lat) {
#pragma unroll
        for (int r = 0; r < 16; ++r) { float* so = F.out + O_GLA + ((size_t)((((b * 2 + l) * 2 + d) * 4 + h) * 64)) * 128 + sl * 32 + c31;
            so[(size_t)crow(r, hh) * 128] = S0[r]; so[(size_t)(32 + crow(r, hh)) * 128] = S1[r]; }
    }
    __syncthreads();
    for (int t = F.wave; t < L; t += NWAVES) {
        const size_t row = (size_t)(row0 + t); const int c = h * 128 + 2 * F.lane;
        const unsigned a = *(const unsigned*)(GS + row * 512 + c), bb = *(const unsigned*)(GS + (size_t)M_TOK * 512 + row * 512 + c), gg = *(const unsigned*)(Z + row * ZP + 1536 + c);
        const float o0 = bflo(a) + bflo(bb), o1 = bfhi(a) + bfhi(bb);
        const float rstd = 1.0f / sqrtf(wave_sum(o0 * o0 + o1 * o1) * (1.0f / 128.0f) + RMS_EPS);
        const float g0 = bflo(gg), g1 = bfhi(gg);
        const float* gn = F.in[I_GNG] + l * 128 + 2 * F.lane;
        *(unsigned*)(YB + row * 512 + c) = pk2(o0 * rstd * gn[0] * (g0 / (1.0f + __expf(-g0))), o1 * rstd * gn[1] * (g1 / (1.0f + __expf(-g1))));
    }
    __syncthreads();
}
constexpr int AT_K = 0, AT_VT = 4608, AT_BUF = 9728;
__device__ __forceinline__ void attn_item(const Frame& F, int l, int item) {
    const bool lat = item < 256; const int ii = lat ? item : item - 256;
    const int b = lat ? ii >> 5 : ii >> 3, kvh = lat ? (ii >> 4) & 1 : (ii >> 2) & 1, qt = lat ? ii & 15 : ii & 3;
    const int L = lat ? L_LAT : L_CTX, row0 = lat ? M_CTX + b * L_LAT : b * L_CTX, q0 = qt * 64;
    const int w = F.wave, lane = F.lane, hh = lane >> 5, c31 = lane & 31, hq = kvh * 4 + (w >> 1), tq = q0 + 32 * (w & 1) + c31;
    const bf16* Z = (const bf16*)(F.ws + WS_Z); bf16* YC = (bf16*)(F.ws + WS_Y) + (size_t)M_TOK * 512;
    const bf16* ck = (const bf16*)(F.ws + WS_CKV) + (size_t)((l * 8 + b) * 256) * 128 + kvh * 64; const bf16* cv = ck + 524288;
    const int j0 = lat ? (q0 - 128 < 0 ? 0 : q0 - 128) : 0, j1 = lat ? (q0 + 192 > L ? L : q0 + 192) : L;
    const int nw = (j1 - j0) >> 5, nt = lat ? nw + 8 : nw;
    bf16x8 qf[4];
    { const bf16* qp = Z + (size_t)(row0 + tq) * ZP + 2048 + hq * 64 + 8 * hh;
#pragma unroll
      for (int s = 0; s < 4; ++s) qf[s] = *(const bf16x8*)(qp + 16 * s); }
    f32x16 O0 = {0.f, 0.f, 0.f, 0.f, 0.f, 0.f, 0.f, 0.f, 0.f, 0.f, 0.f, 0.f, 0.f, 0.f, 0.f, 0.f}, O1 = O0;
    float m = F.in[I_SINK][l * 8 + hq], ls = 1.0f;
    const int st = (w & 3) * 64 + lane, skey = st >> 3, sseg = st & 7; const bool isk = w < 4;
#define AT_SRC(kt) ((kt) < nw ? Z + (size_t)(row0 + j0 + 32 * (kt) + skey) * ZP + (isk ? 2560 : 2688) + kvh * 64 + sseg * 8 : (isk ? ck : cv) + (size_t)(32 * ((kt) - nw) + skey) * 128 + sseg * 8)
#define AT_WRITE(kt, val) do { unsigned char* bp = F.lds + ((kt) & 1) * AT_BUF; \
        if (isk) *(v4u*)(bp + AT_K + skey * 144 + sseg * 16) = (val); \
        else { bf16* vt = (bf16*)(bp + AT_VT) + (sseg * 8) * 40 + skey; vt[0] = (bf16)((val).x & 0xffff); vt[40] = (bf16)((val).x >> 16); vt[80] = (bf16)((val).y & 0xffff); vt[120] = (bf16)((val).y >> 16); \
               vt[160] = (bf16)((val).z & 0xffff); vt[200] = (bf16)((val).z >> 16); vt[240] = (bf16)((val).w & 0xffff); vt[280] = (bf16)((val).w >> 16); } } while (0)
    { const v4u v0 = *(const v4u*)AT_SRC(0); AT_WRITE(0, v0); }
    __syncthreads();
    for (int kt0 = 0; kt0 < nt; ++kt0) {
        int kt = kt0; asm volatile("" : "+s"(kt));
        v4u pre = {0u, 0u, 0u, 0u}; if (kt + 1 < nt) pre = *(const v4u*)AT_SRC(kt + 1);
        const unsigned char* bp = F.lds + (kt & 1) * AT_BUF; const bf16* KT = (const bf16*)(bp + AT_K); const bf16* VT = (const bf16*)(bp + AT_VT);
        f32x16 sc = {0.f, 0.f, 0.f, 0.f, 0.f, 0.f, 0.f, 0.f, 0.f, 0.f, 0.f, 0.f, 0.f, 0.f, 0.f, 0.f};
#pragma unroll
        for (int s = 0; s < 4; ++s) sc = MFMA32(*(const bf16x8*)(KT + c31 * 72 + 16 * s + 8 * hh), qf[s], sc);
        if (lat && kt < nw) { const int jb = j0 + 32 * kt - tq;
#pragma unroll
            for (int r = 0; r < 16; ++r) { const int dj = jb + crow(r, hh); if (dj > 128 || dj < -128) sc[r] = -INFINITY; } }
        float mx = sc[0];
#pragma unroll
        for (int r = 1; r < 16; ++r) mx = fmaxf(mx, sc[r]);
        mx = fmaxf(mx, __shfl_xor(mx, 32));
        const float mn = fmaxf(m, mx), al = __expf(m - mn); m = mn;
        float ps = 0.f;
#pragma unroll
        for (int r = 0; r < 16; ++r) { sc[r] = __expf(sc[r] - mn); ps += sc[r]; }
        ps += __shfl_xor(ps, 32); ls = ls * al + ps;
#pragma unroll
        for (int r = 0; r < 16; ++r) { O0[r] *= al; O1[r] *= al; }
#pragma unroll
        for (int s = 0; s < 2; ++s) { const bf16x8 pf = acc_frag(sc, s);
            O0 = MFMA32(cat4(*(const bf16x4*)(VT + c31 * 40 + 16 * s + 4 * hh), *(const bf16x4*)(VT + c31 * 40 + 16 * s + 8 + 4 * hh)), pf, O0);
            O1 = MFMA32(cat4(*(const bf16x4*)(VT + (32 + c31) * 40 + 16 * s + 4 * hh), *(const bf16x4*)(VT + (32 + c31) * 40 + 16 * s + 8 + 4 * hh)), pf, O1); }
        if (kt + 1 < nt) AT_WRITE(kt + 1, pre);
        __syncthreads();
    }
#undef AT_SRC
#undef AT_WRITE
    const float inv = 1.0f / ls;
    bf16* op = YC + (size_t)(row0 + tq) * 512 + hq * 64 + 4 * hh;
#pragma unroll
    for (int g = 0; g < 4; ++g) {
        v2u w0; w0.x = cvtpk(O0[4 * g] * inv, O0[4 * g + 1] * inv); w0.y = cvtpk(O0[4 * g + 2] * inv, O0[4 * g + 3] * inv); *(v2u*)(op + 8 * g) = w0;
        v2u w1; w1.x = cvtpk(O1[4 * g] * inv, O1[4 * g + 1] * inv); w1.y = cvtpk(O1[4 * g + 2] * inv, O1[4 * g + 3] * inv); *(v2u*)(op + 32 + 8 * g) = w1; }
}
__device__ __forceinline__ void mixer_phase(const Frame& F, int l) {
    for (int it0 = F.bid; it0 < 672; it0 += F.G) {
        Frame G = F; int it = it0;
        { int tid = F.tid; asm volatile("" : "+v"(tid)); asm volatile("" : "+s"(it)); G.tid = tid; G.lane = tid & 63; G.wave = __builtin_amdgcn_readfirstlane(tid >> 6); }
        if (it < 192) s5_item(G, l, it);
        else if (it < 288) gla_item(G, l, it - 192);
        else attn_item(G, l, it - 288);
    }
}

constexpr int N_PHASES = 20;
__global__ void __launch_bounds__(NWAVES * 64, 2) fwd_kernel(Args args) {
    extern __shared__ __attribute__((aligned(16))) unsigned char lds[];
    Frame F;
    F.lds = lds; F.tid = threadIdx.x; F.lane = F.tid & 63; F.wave = __builtin_amdgcn_readfirstlane(F.tid >> 6); F.G = gridDim.x; F.bid = blockIdx.x;
    F.in = (kargs_t)__builtin_amdgcn_kernarg_segment_ptr();
    F.out = (float*)F.in[N_IN]; F.ws = (unsigned char*)F.in[N_IN + 1];
    LAS unsigned char* llds = (LAS unsigned char*)lds;
    for (int u = F.tid; u < (LDS_BYTES - LDSCTL_OFF) / 4; u += NWAVES * 64) ((LAS unsigned*)(llds + LDSCTL_OFF))[u] = 0u;
    __syncthreads();
    XcdBarrier bar; bar.bar = (unsigned*)(F.ws + WS_CTL) + CW_BAR; bar.x = 0; bar.st = nullptr;
    const int ph_lo = args.ph_lo, ph_hi = args.ph_hi;
    if (ph_hi - ph_lo > 1) bar = xcd_barrier_post((unsigned*)(F.ws + WS_CTL) + CW_BAR, (volatile LAS unsigned*)(llds + MISC_OFF) + 8);
    for (int ph = ph_lo; ph < ph_hi; ++ph) {
        { kargs_t kp = (kargs_t)__builtin_amdgcn_kernarg_segment_ptr(); asm volatile("" : "+s"(kp)); F.in = kp; F.out = (float*)kp[N_IN]; F.ws = (unsigned char*)kp[N_IN + 1]; }
        { int tid = threadIdx.x; asm volatile("" : "+v"(tid)); int bid = blockIdx.x; asm volatile("" : "+s"(bid));
          F.tid = tid; F.lane = tid & 63; F.wave = __builtin_amdgcn_readfirstlane(tid >> 6); F.bid = bid; }
        unsigned char* ws = F.ws;
        bf16* WT = (bf16*)(ws + WS_W);
        if (ph == 0) p0_prologue(F);
        else if (ph == 1) norm_phase(F, 0, 0);
        else {
            const int l = (ph - 2) / 9, s = (ph - 2) % 9;
            if (s == 0) {
                pg8::Gemm g{(const bf16*)(ws + WS_XN), WT + WO_IN, M_TOK, NZ, 1024, nullptr, nullptr}; pg8::StaticOrder S; S.init(M_TOK, NZ, F.G, F.bid);
                pg8::EpiWin E{(bf16*)(ws + WS_Z), (bf16*)(ws + WS_G), F.out + O_CK + l * 32768, F.out + O_CV + l * 32768, (const float*)(ws + WS_ROPE)};
                pg8::gemm_phase<pg8::EpiWin, pg8::StaticOrder, true>(llds + RING_OFF, g, S, E, F.tid);
            } else if (s == 1) {
                mixer_phase(F, l);
            } else if (s == 2) {
                pg8::Gemm g{(const bf16*)(ws + WS_XN), WT + WO_GLU, M_TOK, 1024, 512, nullptr, nullptr}; pg8::StaticOrder S; S.init(M_TOK, 1024, F.G, F.bid);
                pg8::EpiGlu<0> E{(bf16*)(ws + WS_XN) + (size_t)M_TOK * 512, 512};
                pg8::gemm_phase<pg8::EpiGlu<0>, pg8::StaticOrder, true>(llds + RING_OFF, g, S, E, F.tid);
            } else if (s == 3) {
                pg8::Gemm g{(const bf16*)(ws + WS_XN) + (size_t)M_TOK * 512, WT + WO_BR, M_TOK, 1024, 512, (const bf16*)(ws + WS_Y), (const bf16*)(ws + WS_Y) + (size_t)M_TOK * 512};
                pg8::BranchOrder S; S.init(M_TOK, 1024, F.G, F.bid);
                pg8::EpiBranch E{(const bf16*)(ws + WS_G), (float*)(ws + WS_Z), (bf16*)(ws + WS_GS)};
                pg8::gemm_phase<pg8::EpiBranch, pg8::BranchOrder, true>(llds + RING_OFF, g, S, E, F.tid);
            } else if (s == 4) {
                pg8::Gemm g{(const bf16*)(ws + WS_GS), WT + WO_OUT, M_TOK, 1024, 1024, nullptr, nullptr}; pg8::StaticOrder S; S.init(M_TOK, 1024, F.G, F.bid);
                pg8::EpiF32 E{(float*)(ws + WS_Z), 1024};
                pg8::gemm_phase<pg8::EpiF32, pg8::StaticOrder, true>(llds + RING_OFF, g, S, E, F.tid);
            } else if (s == 5) {
                norm_phase(F, l, 1);
            } else if (s == 6) {
                pg8::Gemm g{(const bf16*)(ws + WS_XN), WT + WO_W1, M_TOK, FF2, 1024, nullptr, nullptr}; pg8::StaticOrder S; S.init(M_TOK, FF2, F.G, F.bid);
                pg8::EpiGlu<1> E{(bf16*)(ws + WS_G), FFH};
                pg8::gemm_phase<pg8::EpiGlu<1>, pg8::StaticOrder, true>(llds + RING_OFF, g, S, E, F.tid);
            } else if (s == 7) {
                pg8::Gemm g{(const bf16*)(ws + WS_G), WT + WO_W2, M_TOK, 1024, FFH, nullptr, nullptr}; pg8::StaticOrder S; S.init(M_TOK, 1024, F.G, F.bid);
                pg8::EpiF32 E{(float*)(ws + WS_Z), 1024};
                pg8::gemm_phase<pg8::EpiF32, pg8::StaticOrder, true>(llds + RING_OFF, g, S, E, F.tid);
            } else {
                norm_phase(F, l, 2);
                if (l == 0) convert_weights(F, 1);
            }
        }
        if (ph + 1 < ph_hi) xcd_barrier(bar);
    }
}

extern "C" void kernel_launch(void* const* d_in, const int* in_sizes, int n_in, void* d_out, int out_size, void* d_ws, size_t ws_size, hipStream_t stream) {
    static int grid = 0;
    if (grid == 0) {
        if (n_in != N_IN || out_size != (int)O_END || ws_size < WS_END) fprintf(stderr, "kernel_launch: unexpected shapes: n_in %d out %d ws %zu\n", n_in, out_size, ws_size);
        int dev = 0, cus = 0, per_cu = 0;
        if (hipGetDevice(&dev) != hipSuccess || hipDeviceGetAttribute(&cus, hipDeviceAttributeMultiprocessorCount, dev) != hipSuccess || cus <= 0) cus = 256;
        if (hipFuncSetAttribute((const void*)fwd_kernel, hipFuncAttributeMaxDynamicSharedMemorySize, LDS_BYTES) != hipSuccess) fprintf(stderr, "kernel_launch: hipFuncSetAttribute failed\n");
        if (hipOccupancyMaxActiveBlocksPerMultiprocessor(&per_cu, (const void*)fwd_kernel, NWAVES * 64, LDS_BYTES) != hipSuccess || per_cu < 1) fprintf(stderr, "kernel_launch: occupancy query reports %d workgroups per CU\n", per_cu);
        (void)hipGetLastError();
        grid = cus;
    }
    (void)hipMemsetAsync((char*)d_ws + WS_CTL, 0, CTL_ZERO_BYTES, stream);
    Args a{};
    for (int i = 0; i < N_IN; ++i) a.in[i] = (const float*)d_in[i];
    a.out = (float*)d_out; a.ws = (unsigned char*)d_ws;
#if MK_PER_PHASE
    for (int ph = 0; ph < N_PHASES; ++ph) { a.ph_lo = ph; a.ph_hi = ph + 1; hipLaunchKernelGGL(fwd_kernel, dim3(grid), dim3(NWAVES * 64), LDS_BYTES, stream, a); }
#else
    a.ph_lo = 0; a.ph_hi = N_PHASES;
    hipLaunchKernelGGL(fwd_kernel, dim3(grid), dim3(NWAVES * 64), LDS_BYTES, stream, a);
#endif
}
```

```cpp
#include <hip/hip_runtime.h>
#include <cstdio>
#include <cstdint>

#ifndef MK_PER_PHASE
#define MK_PER_PHASE 0
#endif

namespace pg8 {
#define PG8_LAS __attribute__((address_space(3)))
typedef unsigned short bf16_t;
typedef short bf16x8 __attribute__((ext_vector_type(8)));
typedef float f32x4 __attribute__((ext_vector_type(4)));
typedef float f32x2 __attribute__((ext_vector_type(2)));
typedef unsigned u32x4 __attribute__((ext_vector_type(4)));
typedef unsigned u32x2 __attribute__((ext_vector_type(2)));
constexpr int BM = 256, BK = 64, HALF = 128, HTB = HALF * BK * 2  , STAGE_BYTES = 8 * HTB, NXCD = 8, WGM = 8;

__host__ __device__ __forceinline__ int lds_byte(int r, int c) { const int st = (r >> 4) * 2 + (c >> 5), rr = r & 15, cc = c & 31, ob = rr * 64 + cc * 2; return st * 1024 + (ob ^ (((ob >> 9) & 1) << 5)); }
__host__ __device__ __forceinline__ void stage_rc(int b, int& R, int& C) { const int st = b / 1024, sb = b % 1024, swz = sb ^ (((sb >> 9) & 1) << 5); R = (st >> 1) * 16 + swz / 64; C = (st & 1) * 32 + (swz % 64) / 2; }
__host__ __device__ __forceinline__ int perm32(int rho) { const int n = rho >> 4, i = rho & 15; return 8 * (i >> 2) + 4 * n + (i & 3); }

struct Unit { int pm, pn, sel; };
struct Gemm { const bf16_t* A; const bf16_t* Bt; int M, N, K; const bf16_t* A1; const bf16_t* A2; };

struct StaticOrder {
    int nM, nN, nwg, G, c;
    __host__ __device__ void init(int M, int N, int G_, int c_) { nM = M / BM; nN = N / BM; nwg = nM * nN; G = G_; c = c_; }
    __host__ __device__ bool next(int i, Unit& u) const {
        const long L = (long)i * G + c; if (L >= nwg) return false;
        int wgid = (int)L; { const int q = nwg / NXCD, r = nwg % NXCD, xcd = wgid % NXCD, off = wgid / NXCD; wgid = (xcd < r ? xcd * (q + 1) : r * (q + 1) + (xcd - r) * q) + off; }
        const int nig = WGM * nN, gid = wgid / nig, fm = gid * WGM, gsz = (nM - fm) < WGM ? (nM - fm) : WGM;
        u.pm = fm + ((wgid % nig) % gsz); u.pn = (wgid % nig) / gsz; u.sel = 0; return true;
    }
    __device__ __forceinline__ const char* a_base(const Gemm& g, const Unit& u, size_t tstep) const { return (const char*)g.A + (size_t)u.pm * tstep; }
    __device__ __forceinline__ const char* b_base(const Gemm& g, const Unit& u, size_t tstep) const { return (const char*)g.Bt + (size_t)u.pn * tstep; }
};
struct BranchOrder {
    StaticOrder so;
    __host__ __device__ void init(int M, int N, int G_, int c_) { so.init(M, N, G_, c_); }
    __host__ __device__ bool next(int i, Unit& u) const { if (i >= 3) return false; if (!so.next(0, u)) return false; u.sel = i; return true; }
    __device__ __forceinline__ const char* a_base(const Gemm& g, const Unit& u, size_t tstep) const { const bf16_t* a = u.sel == 0 ? g.A : (u.sel == 1 ? g.A1 : g.A2); return (const char*)a + (size_t)u.pm * tstep; }
    __device__ __forceinline__ const char* b_base(const Gemm& g, const Unit& u, size_t tstep) const { return (const char*)g.Bt + (size_t)(u.sel * so.nN + u.pn) * tstep; }
};

__device__ __forceinline__ unsigned cvt_pk_bf16(float lo, float hi) { unsigned r; asm volatile("v_cvt_pk_bf16_f32 %0, %1, %2" : "=v"(r) : "v"(lo), "v"(hi)); return r; }
__device__ __forceinline__ float bf_lo(unsigned w) { return __builtin_bit_cast(float, w << 16); }
__device__ __forceinline__ float bf_hi(unsigned w) { return __builtin_bit_cast(float, w & 0xffff0000u); }
__device__ __forceinline__ float sigmoidf_(float x) { return 1.0f / (1.0f + __expf(-x)); }


struct EpiWin {
    static constexpr bool PERM = false, AFTER_DRAIN = false;
    bf16_t* Z; bf16_t* G; float* outk; float* outv; const float* rope;
    __device__ __forceinline__ void operator()(const f32x4 (&acc)[2][2][4][2], const Unit& u, int wr, int wc, int fr, int fq) const {
        const bool lat = u.pm >= 16;
        int rowb = u.pm * BM + wr * 64 + fr; asm volatile("" : "+v"(rowb));
#pragma unroll
        for (int bj = 0; bj < 2; ++bj) {
            const int c32 = u.pn * BM + bj * HALF + wc * 32;
            if (c32 >= 3072) {
#pragma unroll
                for (int ai = 0; ai < 2; ++ai)
#pragma unroll
                    for (int m = 0; m < 4; ++m) { bf16_t* gp = G + (size_t)(rowb + ai * HALF + m * 16) * 3072 + (c32 - 3072) + 4 * fq;
#pragma unroll
                        for (int n = 0; n < 2; ++n) { const f32x4 v = acc[ai][bj][m][n]; u32x2 w; w.x = cvt_pk_bf16(sigmoidf_(v[0]), sigmoidf_(v[1])); w.y = cvt_pk_bf16(sigmoidf_(v[2]), sigmoidf_(v[3])); *(u32x2*)(gp + 16 * n) = w; } }
            } else if (c32 >= 2848) {
            } else if (lat && c32 >= 2048 && c32 < 2688) {
                const float sc = c32 < 2560 ? 0.125f : 1.0f;
#pragma unroll
                for (int ai = 0; ai < 2; ++ai)
#pragma unroll
                    for (int m = 0; m < 4; ++m) { const int row = rowb + ai * HALF + m * 16, t = (row - 4096) & 1023, pos = (c32 & 32) ? (t & 63) : (t >> 6);
                        const f32x4* rp = (const f32x4*)(rope + (pos * 16 + 4 * fq) * 2); const f32x4 r0 = rp[0], r1 = rp[1];
                        const f32x4 x1 = acc[ai][bj][m][0] * sc, x2 = acc[ai][bj][m][1] * sc;
                        const f32x4 cs = (f32x4){r0[0], r0[2], r1[0], r1[2]}, sn = (f32x4){r0[1], r0[3], r1[1], r1[3]};
                        const f32x4 o1 = x1 * cs - x2 * sn, o2 = x1 * sn + x2 * cs;
                        bf16_t* zp = Z + (size_t)row * 2848 + c32 + 4 * fq;
                        u32x2 w; w.x = cvt_pk_bf16(o1[0], o1[1]); w.y = cvt_pk_bf16(o1[2], o1[3]); *(u32x2*)zp = w;
                        w.x = cvt_pk_bf16(o2[0], o2[1]); w.y = cvt_pk_bf16(o2[2], o2[3]); *(u32x2*)(zp + 16) = w; }
            } else {
                const float sc = ((c32 >= 512 && c32 < 768) || (c32 >= 2048 && c32 < 2560)) ? 0.125f : 1.0f;
                const bool kv32 = (!lat) && c32 >= 2560 && c32 < 2816;
                float* ob = c32 < 2688 ? outk : outv; const int cc = (c32 < 2688 ? c32 - 2560 : c32 - 2688) + 4 * fq;
#pragma unroll
                for (int ai = 0; ai < 2; ++ai)
#pragma unroll
                    for (int m = 0; m < 4; ++m) { const int row = rowb + ai * HALF + m * 16; bf16_t* zp = Z + (size_t)row * 2848 + c32 + 4 * fq;
#pragma unroll
                        for (int n = 0; n < 2; ++n) { const f32x4 v = acc[ai][bj][m][n] * sc; u32x2 w; w.x = cvt_pk_bf16(v[0], v[1]); w.y = cvt_pk_bf16(v[2], v[3]); *(u32x2*)(zp + 16 * n) = w;
                            if (kv32) *(f32x4*)(ob + (size_t)u.pm * 65536 + (size_t)(row & 255) * 128 + cc + 16 * n) = v; } }
            }
        }
    }
};
template <int MODE> struct EpiGlu {
    static constexpr bool PERM = true, AFTER_DRAIN = false;
    bf16_t* O; int ldc;
    __device__ __forceinline__ void operator()(const f32x4 (&acc)[2][2][4][2], const Unit& u, int wr, int wc, int fr, int fq) const {
        int row0 = u.pm * BM + wr * 64 + fr; asm volatile("" : "+v"(row0)); const int col0 = u.pn * HALF + wc * 32 + 8 * fq;
#pragma unroll
        for (int ai = 0; ai < 2; ++ai)
#pragma unroll
            for (int m = 0; m < 4; ++m) { bf16_t* rowp = O + (size_t)(row0 + ai * HALF + m * 16) * ldc + col0;
                f32x4 v[2];
#pragma unroll
                for (int n = 0; n < 2; ++n) { const f32x4 a = acc[ai][0][m][n], b = acc[ai][1][m][n];
#pragma unroll
                    for (int j = 0; j < 4; ++j) v[n][j] = MODE == 0 ? a[j] * sigmoidf_(b[j]) : a[j] * sigmoidf_(a[j]) * b[j]; }
                u32x4 w; w.x = cvt_pk_bf16(v[0][0], v[0][1]); w.y = cvt_pk_bf16(v[0][2], v[0][3]); w.z = cvt_pk_bf16(v[1][0], v[1][1]); w.w = cvt_pk_bf16(v[1][2], v[1][3]);
                *(u32x4*)rowp = w; }
    }
};
struct EpiBranch {
    static constexpr bool PERM = false, AFTER_DRAIN = false;
    const bf16_t* G; float* MF; bf16_t* MB;
    __device__ __forceinline__ void operator()(const f32x4 (&acc)[2][2][4][2], const Unit& u, int wr, int wc, int fr, int fq) const {
        int row0 = u.pm * BM + wr * 64 + fr; asm volatile("" : "+v"(row0)); const int col0 = u.pn * BM + wc * 32 + 4 * fq, sel = u.sel;
#pragma unroll
        for (int ai = 0; ai < 2; ++ai)
#pragma unroll
            for (int m = 0; m < 4; ++m) { const size_t row = (size_t)(row0 + ai * HALF + m * 16);
#pragma unroll
                for (int bj = 0; bj < 2; ++bj)
#pragma unroll
                    for (int n = 0; n < 2; ++n) { const int col = col0 + bj * HALF + n * 16;
                        const u32x2 gw = *(const u32x2*)(G + row * 3072 + sel * 1024 + col);
                        f32x4 v = acc[ai][bj][m][n] * (f32x4){bf_lo(gw.x), bf_hi(gw.x), bf_lo(gw.y), bf_hi(gw.y)};
                        if (sel > 0) v += *(const f32x4*)(MF + row * 1024 + col);
                        if (sel < 2) *(f32x4*)(MF + row * 1024 + col) = v;
                        else { u32x2 w; w.x = cvt_pk_bf16(v[0], v[1]); w.y = cvt_pk_bf16(v[2], v[3]); *(u32x2*)(MB + row * 1024 + col) = w; } } }
    }
};
struct EpiF32 {
    static constexpr bool PERM = false, AFTER_DRAIN = false;
    float* C; int ldc;
    __device__ __forceinline__ void operator()(const f32x4 (&acc)[2][2][4][2], const Unit& u, int wr, int wc, int fr, int fq) const {
        int row0 = u.pm * BM + wr * 64 + fr; asm volatile("" : "+v"(row0)); const int col0 = u.pn * BM + wc * 32 + 4 * fq;
#pragma unroll
        for (int ai = 0; ai < 2; ++ai)
#pragma unroll
            for (int m = 0; m < 4; ++m) { float* rowp = C + (size_t)(row0 + ai * HALF + m * 16) * ldc + col0;
#pragma unroll
                for (int bj = 0; bj < 2; ++bj)
#pragma unroll
                    for (int n = 0; n < 2; ++n) *(f32x4*)(rowp + bj * HALF + n * 16) = acc[ai][bj][m][n]; }
    }
};

template <class Epi, class Sched, bool ALIGN_EPI>
__device__ __forceinline__ void gemm_phase(PG8_LAS unsigned char* lds, const Gemm g, const Sched& S, const Epi& E, const int tid) {
    const int wid = __builtin_amdgcn_readfirstlane(tid >> 6), lane = tid & 63, wr = wid >> 2, wc = wid & 3, fr = lane & 15, fq = lane >> 4;
    const int K = g.K, nt = K / BK;
    unsigned voffA[2], voffB[2];
#pragma unroll
    for (int i = 0; i < 2; ++i) { int R, C; stage_rc(tid * 16 + i * 8192, R, C); const int Rb = Epi::PERM ? ((R & ~31) + perm32(R & 31)) : R;
        voffA[i] = (unsigned)(R * K + C) * 2u; voffB[i] = (unsigned)(Rb * K + C) * 2u; }
    const size_t kstep = (size_t)(BK * 2);
    const size_t hstep = (size_t)HALF * K * 2;
    const size_t tstep = 2 * hstep;
    const unsigned ldsw = (unsigned)wid * 1024u;
    const int aoff = lds_byte(wr * 64 + fr, fq * 8), boff = lds_byte(wc * 32 + fr, fq * 8);
#define PG8_SA(b, h) (((b) * 2 + (h)) * HTB)
#define PG8_SB(b, h) ((4 + (b) * 2 + (h)) * HTB)
#define PG8_STAGE(bufoff, gbase, voff) do { _Pragma("unroll") for (int _i = 0; _i < 2; ++_i) \
        __builtin_amdgcn_global_load_lds((const unsigned*)((const char*)(gbase) + (voff)[_i]), (PG8_LAS unsigned*)(lds + (bufoff) + ldsw + _i * 8192), 16, 0, 0); } while (0)
#define PG8_LDA(dst, b, h) do { _Pragma("unroll") for (int m = 0; m < 4; ++m) _Pragma("unroll") for (int k = 0; k < 2; ++k) dst[m][k] = *(const PG8_LAS bf16x8*)(lds + PG8_SA(b, h) + aoff + m * 2048 + k * 1024); } while (0)
#define PG8_LDB(dst, b, h) do { _Pragma("unroll") for (int n = 0; n < 2; ++n) _Pragma("unroll") for (int k = 0; k < 2; ++k) dst[n][k] = *(const PG8_LAS bf16x8*)(lds + PG8_SB(b, h) + boff + n * 2048 + k * 1024); } while (0)
#define PG8_MMA(ai, bj, At, Bt) do { __builtin_amdgcn_s_setprio(1); _Pragma("unroll") for (int m = 0; m < 4; ++m) _Pragma("unroll") for (int n = 0; n < 2; ++n) _Pragma("unroll") for (int k = 0; k < 2; ++k) \
        acc[ai][bj][m][n] = __builtin_amdgcn_mfma_f32_16x16x32_bf16(Bt[n][k], At[m][k], acc[ai][bj][m][n], 0, 0, 0); __builtin_amdgcn_s_setprio(0); } while (0)
#define PG8_WAIT_V(n) asm volatile("s_waitcnt vmcnt(" #n ")" ::: "memory")
#define PG8_WAIT_L(n) asm volatile("s_waitcnt lgkmcnt(" #n ")" ::: "memory")
#define PG8_BAR __builtin_amdgcn_s_barrier()
#define PG8_SCHED __builtin_amdgcn_sched_barrier(0)
    Unit cur, nxt; int ui = 0;
    if (!S.next(0, cur)) return;
    f32x4 acc[2][2][4][2];
#pragma unroll
    for (int a = 0; a < 2; ++a)
#pragma unroll
        for (int b = 0; b < 2; ++b)
#pragma unroll
            for (int m = 0; m < 4; ++m)
#pragma unroll
                for (int n = 0; n < 2; ++n) acc[a][b][m][n] = (f32x4){0.f, 0.f, 0.f, 0.f};
    bf16x8 At[4][2], B0[2][2], B1[2][2];
    const char* cA = S.a_base(g, cur, tstep); const char* cB = S.b_base(g, cur, tstep);
    PG8_STAGE(PG8_SB(0, 0), cB, voffB); PG8_STAGE(PG8_SB(0, 1), cB + hstep, voffB); PG8_STAGE(PG8_SA(0, 0), cA, voffA); PG8_STAGE(PG8_SA(0, 1), cA + hstep, voffA);
    if (wr == 1) PG8_BAR;
    PG8_WAIT_V(2); PG8_BAR;
    PG8_STAGE(PG8_SB(1, 0), cB + kstep, voffB); PG8_STAGE(PG8_SA(1, 0), cA + kstep, voffA); PG8_STAGE(PG8_SB(1, 1), cB + hstep + kstep, voffB);
    PG8_WAIT_V(6); PG8_BAR;
    for (;;) {
        const bool has_next = S.next(ui + 1, nxt);
        const char* nA = has_next ? S.a_base(g, nxt, tstep) : cA; const char* nB = has_next ? S.b_base(g, nxt, tstep) : cB;
        for (int t = 0; t < nt; t += 2) {
            const bool last = (t == nt - 2);
            const char* a1 = cA + (size_t)(t + 1) * kstep;
            const char* a2 = last ? nA : cA + (size_t)(t + 2) * kstep; const char* b2 = last ? nB : cB + (size_t)(t + 2) * kstep;
            const char* a3 = a2 + kstep; const char* b3 = b2 + kstep;
            PG8_LDB(B0, 0, 0); PG8_LDB(B1, 0, 1); PG8_SCHED; PG8_LDA(At, 0, 0); PG8_STAGE(PG8_SA(1, 1), a1 + hstep, voffA);
            PG8_WAIT_V(8); PG8_WAIT_L(0); PG8_BAR; PG8_MMA(0, 0, At, B0); PG8_MMA(0, 1, At, B1); PG8_BAR; PG8_SCHED;
            PG8_LDA(At, 0, 1); PG8_STAGE(PG8_SB(0, 0), b2, voffB); PG8_STAGE(PG8_SB(0, 1), b2 + hstep, voffB); PG8_STAGE(PG8_SA(0, 0), a2, voffA);
            PG8_WAIT_V(8); PG8_WAIT_L(0); PG8_BAR; PG8_MMA(1, 0, At, B0); PG8_MMA(1, 1, At, B1); PG8_BAR; PG8_SCHED;
            PG8_LDB(B0, 1, 0); PG8_LDB(B1, 1, 1); PG8_SCHED; PG8_LDA(At, 1, 0); PG8_STAGE(PG8_SA(0, 1), a2 + hstep, voffA);
            PG8_WAIT_V(8); PG8_WAIT_L(0); PG8_BAR; PG8_MMA(0, 0, At, B0); PG8_MMA(0, 1, At, B1); PG8_BAR; PG8_SCHED;
            PG8_LDA(At, 1, 1); PG8_STAGE(PG8_SB(1, 0), b3, voffB); PG8_STAGE(PG8_SB(1, 1), b3 + hstep, voffB); PG8_STAGE(PG8_SA(1, 0), a3, voffA);
            PG8_WAIT_V(8); PG8_WAIT_L(0); PG8_BAR; PG8_MMA(1, 0, At, B0); PG8_MMA(1, 1, At, B1); PG8_BAR; PG8_SCHED;
        }
        if constexpr (ALIGN_EPI) { if (wr == 0) PG8_BAR; }
        E(acc, cur, wr, wc, fr, fq);
        if (!has_next) break;
#pragma unroll
        for (int a = 0; a < 2; ++a)
#pragma unroll
            for (int b = 0; b < 2; ++b)
#pragma unroll
                for (int m = 0; m < 4; ++m)
#pragma unroll
                    for (int n = 0; n < 2; ++n) acc[a][b][m][n] = (f32x4){0.f, 0.f, 0.f, 0.f};
        cur = nxt; cA = nA; cB = nB; ++ui;
        if constexpr (ALIGN_EPI) { if (wr == 1) PG8_BAR; }
    }
    PG8_WAIT_V(0);
    if constexpr (!ALIGN_EPI) { if (wr == 0) PG8_BAR; }
    PG8_BAR;
#undef PG8_SA
#undef PG8_SB
#undef PG8_STAGE
#undef PG8_LDA
#undef PG8_LDB
#undef PG8_MMA
#undef PG8_WAIT_V
#undef PG8_WAIT_L
#undef PG8_BAR
#undef PG8_SCHED
}
}

constexpr int NWAVES = 8;
constexpr int DM = 1024, M_CTX = 4096, M_TOK = 12288, L_CTX = 256, L_LAT = 1024;
constexpr int ZP = 2848, GP = 3072, NZ = 6144, D_IN = 5920, FFH = 2816, FF2 = 5632;
constexpr float RMS_EPS = 1e-6f;
constexpr size_t O_Y = 0, O_CK = 12582912, O_CV = 13631488, O_S5 = 14680064, O_GLA = 14942208, O_END = 17039360;
enum { I_XP = 0, I_XS, I_CK, I_CV, I_SS5, I_SGLA, I_C, I_CCTX, I_WMOD, I_BMOD, I_NORMG, I_WIN, I_LRE, I_LIM, I_LSTEP, I_BRE, I_BIM, I_CRE, I_CIM, I_S5D, I_WGLU, I_WGK, I_BGK, I_GNG, I_SINK, I_WBR, I_WOUT, I_W1, I_W2, N_IN };

constexpr size_t MiB = 1u << 20;
constexpr size_t WS_CTL = 0, CTL_ZERO_BYTES = 64 * 1024;
constexpr size_t WS_MOD = 64 * 1024;
constexpr size_t WS_ROPE = 512 * 1024;
constexpr size_t WS_CKV = 1 * MiB;
constexpr size_t WS_W = 3 * MiB;
constexpr size_t WS_XN = 38 * MiB;
constexpr size_t WS_Z = 62 * MiB;
constexpr size_t WS_G = 129 * MiB;
constexpr size_t WS_GS = 201 * MiB;
constexpr size_t WS_Y = 225 * MiB;
constexpr size_t WS_END = 249 * MiB;
constexpr size_t WO_IN = 0, WO_GLU = 6291456, WO_BR = 6815744, WO_OUT = 8388608, WO_W1 = 9437184, WO_W2 = 15204352, WO_END = 18087936;
static_assert(WS_W + WO_END * 2 <= WS_XN && WS_XN + (size_t)M_TOK * 1024 * 2 <= WS_Z && WS_Z + (size_t)M_TOK * ZP * 2 <= WS_G && WS_G + (size_t)M_TOK * GP * 2 <= WS_GS && WS_GS + (size_t)M_TOK * 1024 * 2 <= WS_Y && WS_Y + (size_t)M_TOK * 1024 * 2 <= WS_END, "d_ws map");
constexpr int CW_BAR = 1024;

constexpr int RING_OFF = 0, RING_BYTES = 131072;
constexpr int LDSCTL_OFF = RING_BYTES, MISC_OFF = LDSCTL_OFF + 320;
constexpr int LDS_BYTES = 147456;
static_assert(MISC_OFF + 128 <= LDS_BYTES, "LDS map");

#define GAS __attribute__((address_space(1)))
#define LAS __attribute__((address_space(3)))
typedef unsigned short bf16;
typedef unsigned v4u __attribute__((ext_vector_type(4)));
typedef unsigned v2u __attribute__((ext_vector_type(2)));
typedef float f32x4 __attribute__((ext_vector_type(4)));
#define LDS_WAIT() asm volatile("s_waitcnt lgkmcnt(0)" ::: "memory")
__device__ __forceinline__ unsigned f2bf(float f) { unsigned u = __builtin_bit_cast(unsigned, f); return (u + 0x7fffu + ((u >> 16) & 1u)) >> 16; }
__device__ __forceinline__ unsigned pk2(float lo, float hi) { return f2bf(lo) | (f2bf(hi) << 16); }
__device__ __forceinline__ float bf2f(bf16 b) { return __builtin_bit_cast(float, ((unsigned)b) << 16); }
__device__ __forceinline__ float bflo(unsigned w) { return __builtin_bit_cast(float, w << 16); }
__device__ __forceinline__ float bfhi(unsigned w) { return __builtin_bit_cast(float, w & 0xffff0000u); }

#define XB_TMO      128
#define XB_XCNT(j)  (256  + 64 * (j))
#define XB_XSUB(j)  (1280 + 64 * (j))
#define XB_XGEN(j)  (2304 + 64 * (j))
#define XB_TOP      3328
#define XB_TOPGEN   3392
#define XCD_BAR_WORDS 3456
#define XB_SPIN_CAP (1u << 22)

__device__ __forceinline__ unsigned xb_ld(unsigned* p)              { return __hip_atomic_load(p, __ATOMIC_RELAXED, __HIP_MEMORY_SCOPE_AGENT); }
__device__ __forceinline__ unsigned xb_add(unsigned* p, unsigned v) { return __hip_atomic_fetch_add(p, v, __ATOMIC_RELAXED, __HIP_MEMORY_SCOPE_AGENT); }
__device__ __forceinline__ unsigned xb_xcc_id() { return (unsigned)__builtin_amdgcn_s_getreg((3 << 11) | 20) & 0xFu; }
#define XB_SPIN(cond, bar) do { unsigned _sp = 0; while (cond) { __builtin_amdgcn_s_sleep(1); \
    if ((++_sp & 255u) == 0u) { if (xb_ld(&(bar)[XB_TMO])) break; if (_sp > XB_SPIN_CAP) { atomicAdd(&(bar)[XB_TMO], 1u); break; } } } } while (0)

struct XcdBarrier {
    unsigned* bar; unsigned x;
    volatile LAS unsigned* st;
};

__device__ __forceinline__ XcdBarrier xcd_barrier_post(unsigned* bar, volatile LAS unsigned* st) {
    XcdBarrier b; b.bar = bar; b.x = xb_xcc_id(); b.st = st;
    if (threadIdx.x == 0) (void)xb_add(&bar[XB_XCNT(b.x)], 1u);
    return b;
}
__device__ __forceinline__ void xcd_barrier_complete(unsigned* bar, unsigned x, unsigned& nloc, unsigned& nx) {
    const unsigned G = gridDim.x * gridDim.y * gridDim.z;
    unsigned sum, cnt, mine, sp = 0u;
    for (;;) {
        sum = 0u; cnt = 0u; mine = 0u;
#pragma unroll
        for (unsigned j = 0; j < 16; ++j) { const unsigned c = xb_ld(&bar[XB_XCNT(j)]); sum += c; cnt += (c > 0u) ? 1u : 0u; mine = (j == x) ? c : mine; }
        if (sum == G) break;
        __builtin_amdgcn_s_sleep(1);
        if ((++sp & 255u) == 0u) { if (xb_ld(&bar[XB_TMO])) break; if (sp > XB_SPIN_CAP) { atomicAdd(&bar[XB_TMO], 1u); break; } }
    }
    nloc = mine > 0u ? mine : 1u; nx = cnt > 0u ? cnt : 1u;
}

__device__ __forceinline__ void xcd_barrier(const XcdBarrier& b) {
    asm volatile("s_waitcnt vmcnt(0)" ::: "memory");
    __syncthreads();
    if (threadIdx.x == 0) {
        unsigned* bar = b.bar;
        __builtin_amdgcn_s_waitcnt(0);
        unsigned nloc = b.st[0], nx = b.st[1];
        if (nloc == 0u) { xcd_barrier_complete(bar, b.x, nloc, nx); b.st[0] = nloc; b.st[1] = nx; }
        const unsigned old = xb_add(&bar[XB_XSUB(b.x)], 1u);
        const unsigned gen = old / nloc;
        if (old + 1u == (gen + 1u) * nloc) {
            __builtin_amdgcn_fence(__ATOMIC_RELEASE, "agent");
            asm volatile("s_waitcnt vmcnt(0)" ::: "memory");
            const unsigned og = xb_add(&bar[XB_TOP], 1u);
            const unsigned tg = og / nx;
            if (og + 1u == (tg + 1u) * nx) xb_add(&bar[XB_TOPGEN], 1u);
            else XB_SPIN(xb_ld(&bar[XB_TOPGEN]) == tg, bar);
            __builtin_amdgcn_fence(__ATOMIC_ACQUIRE, "agent");
            xb_add(&bar[XB_XGEN(b.x)], 1u);
            asm volatile("s_waitcnt vmcnt(0)" ::: "memory");
        } else {
            XB_SPIN(xb_ld(&bar[XB_XGEN(b.x)]) == gen, bar);
            __builtin_amdgcn_fence(__ATOMIC_ACQUIRE, "agent");
            asm volatile("s_waitcnt vmcnt(0)" ::: "memory");
        }
    }
    __syncthreads();
}


struct Args { const float* in[N_IN]; float* out; unsigned char* ws; int ph_lo, ph_hi; };
static_assert(sizeof(Args) == (N_IN + 2) * 8 + 8, "Args has no padding");
typedef const float* cfptr_t;
typedef const __attribute__((address_space(4))) cfptr_t* kargs_t;
struct Frame {
    unsigned char* lds;
    int tid, lane, wave, G, bid;
    kargs_t in; float* out; unsigned char* ws;
};
__device__ __forceinline__ float wave_sum(float v) {
#pragma unroll
    for (int o = 1; o < 64; o <<= 1) v += __shfl_xor(v, o);
    return v;
}
__device__ __forceinline__ const float* xin_row(const Frame& F, int row) { return row < M_CTX ? F.in[I_XP] + (size_t)row * DM : F.in[I_XS] + (size_t)(row - M_CTX) * DM; }
__device__ __forceinline__ int path_of(int row) { return row < M_CTX ? 0 : 1 + ((row - M_CTX) >> 10); }

__device__ __forceinline__ int map_row(int mapk, int n0) {
    if (mapk == 0) return n0;
    if (mapk == 1) { if (n0 < 2048) return n0; if (n0 < 2080) return 2816 + (n0 - 2048); if (n0 < 2848) return 2048 + (n0 - 2080); return 3072 + (n0 - 2848); }
    const int half = mapk == 2 ? 512 : 2816;
    if (n0 < half) return (n0 / 128) * 256 + (n0 % 128);
    const int s = n0 - half; return (s / 128) * 256 + 128 + (s % 128);
}
__device__ __forceinline__ void p0_transpose_item(const float* W, int K, int N, bf16* WT, int mapk, float* scr, int item, int lane) {
    const int nblk = N / 32, kb = item / nblk, nb = item % nblk, k0 = 64 * kb, n0 = 32 * nb, d0 = map_row(mapk, n0);
#pragma unroll 8
    for (int i = 0; i < 32; ++i) { const int kk = 2 * i + (lane >> 5); scr[kk * 33 + (lane & 31)] = W[(size_t)(k0 + kk) * N + n0 + (lane & 31)]; }
    LDS_WAIT(); asm volatile("" ::: "memory");
    const int c = lane & 7;
#pragma unroll
    for (int j = 0; j < 4; ++j) { const int n = (lane >> 3) + 8 * j; const float* s = scr + (8 * c) * 33 + n;
        v4u o; o.x = pk2(s[0 * 33], s[1 * 33]); o.y = pk2(s[2 * 33], s[3 * 33]); o.z = pk2(s[4 * 33], s[5 * 33]); o.w = pk2(s[6 * 33], s[7 * 33]);
        *(v4u*)(WT + (size_t)(d0 + n) * K + k0 + 8 * c) = o; }
    LDS_WAIT(); asm volatile("" ::: "memory");
}
__device__ __forceinline__ void convert_weights(const Frame& F, int l) {
    float* scr = (float*)(F.lds + RING_OFF + F.wave * 16384);
    bf16* WT = (bf16*)(F.ws + WS_W);
    const int gw = F.bid * NWAVES + F.wave, NGW = F.G * NWAVES;
    constexpr int I0 = 16 * 185, I1 = 8 * 32, I2 = 3 * 8 * 32, I3 = 16 * 32, I4 = 16 * 176, I5 = 44 * 32;
    for (int it = gw; it < I0 + I1 + I2 + I3 + I4 + I5; it += NGW) {
        int r = it;
        if (r < I0) { p0_transpose_item(F.in[I_WIN] + (size_t)l * 1024 * D_IN, 1024, D_IN, WT + WO_IN, 1, scr, r, F.lane); continue; } r -= I0;
        if (r < I1) { p0_transpose_item(F.in[I_WGLU] + (size_t)l * 512 * 1024, 512, 1024, WT + WO_GLU, 2, scr, r, F.lane); continue; } r -= I1;
        if (r < I2) { const int n = r / 256; p0_transpose_item(F.in[I_WBR] + (size_t)(l * 3 + n) * 512 * 1024, 512, 1024, WT + WO_BR + (size_t)n * 1024 * 512, 0, scr, r % 256, F.lane); continue; } r -= I2;
        if (r < I3) { p0_transpose_item(F.in[I_WOUT] + (size_t)l * 1024 * 1024, 1024, 1024, WT + WO_OUT, 0, scr, r, F.lane); continue; } r -= I3;
        if (r < I4) { p0_transpose_item(F.in[I_W1] + (size_t)l * 1024 * FF2, 1024, FF2, WT + WO_W1, 3, scr, r, F.lane); continue; } r -= I4;
        p0_transpose_item(F.in[I_W2] + (size_t)l * FFH * 1024, FFH, 1024, WT + WO_W2, 0, scr, r, F.lane);
    }
}
__device__ __forceinline__ void mod_items(const Frame& F) {
    float* SC = (float*)(F.lds);
    float* RED = (float*)(F.lds + 40960);
    float* MOD = (float*)(F.ws + WS_MOD);
    if (F.bid >= 192) return;
    for (int i = F.tid; i < 9 * 1024; i += NWAVES * 64) { const float c = i < 1024 ? F.in[I_CCTX][i] : F.in[I_C][i - 1024]; SC[i] = c / (1.0f + __expf(-c)); }
    __syncthreads();
    const int item = F.bid, l = item / 96, col = (item % 96) * 64 + F.lane;
    const float* wm = F.in[I_WMOD] + ((size_t)l * 1024 + F.wave * 128) * 6144 + col;
    float acc[9];
#pragma unroll
    for (int r = 0; r < 9; ++r) acc[r] = 0.f;
#pragma unroll 8
    for (int kk = 0; kk < 128; ++kk) { const float wv = wm[(size_t)kk * 6144]; const int k = F.wave * 128 + kk;
#pragma unroll
        for (int r = 0; r < 9; ++r) acc[r] += SC[r * 1024 + k] * wv; }
#pragma unroll
    for (int r = 0; r < 9; ++r) RED[(F.wave * 9 + r) * 64 + F.lane] = acc[r];
    __syncthreads();
    for (int o = F.tid; o < 576; o += NWAVES * 64) { const int r = o >> 6, ln = o & 63; float s = F.in[I_BMOD][l * 6144 + (item % 96) * 64 + ln];
#pragma unroll
        for (int w = 0; w < 8; ++w) s += RED[(w * 9 + r) * 64 + ln];
        MOD[(size_t)(l * 9 + r) * 6144 + (item % 96) * 64 + ln] = s; }
    __syncthreads();
}
__device__ __forceinline__ void p0_prologue(const Frame& F) {
    mod_items(F);
    const int gt = F.bid * (NWAVES * 64) + F.tid, NGT = F.G * NWAVES * 64;
    if (gt < 1024) { const int pos = gt >> 4, q = gt & 15; const float inv = powf(10000.0f, -(float)q / 16.0f), ang = (float)pos * inv; float* rp = (float*)(F.ws + WS_ROPE); rp[gt * 2] = cosf(ang); rp[gt * 2 + 1] = sinf(ang); }
    { bf16* ck = (bf16*)(F.ws + WS_CKV); bf16* cv = ck + 524288;
      for (int i = gt; i < 524288; i += NGT) { const int c = i & 127, j = (i >> 7) & 255, b = (i >> 15) & 7, l = i >> 18; const size_t s = ((size_t)((b * 2 + l) * 256 + j)) * 128 + c;
          ck[i] = (bf16)f2bf(F.in[I_CK][s]); cv[i] = (bf16)f2bf(F.in[I_CV][s]); } }
    convert_weights(F, 0);
}

__device__ __forceinline__ void norm_phase(const Frame& F, int l, int mode) {
    const int gw = F.bid * NWAVES + F.wave, NGW = F.G * NWAVES;
    const float* MOD = (const float*)(F.ws + WS_MOD);
    const float* RAW = (const float*)(F.ws + WS_Z);
    bf16* XN = (bf16*)(F.ws + WS_XN);
    float* X = F.out + O_Y;
    for (int row = gw; row < M_TOK; row += NGW) {
        const int pb = path_of(row);
        const float* modl = MOD + (size_t)(l * 9 + pb) * 6144;
        const float* ng = F.in[I_NORMG] + l * 4096;
        const float* xs = (mode == 2 || l == 1) ? X + (size_t)row * DM : xin_row(F, row);
        f32x4 xv[4];
#pragma unroll
        for (int j = 0; j < 4; ++j) xv[j] = ((const f32x4*)xs)[F.lane + 64 * j];
        if (mode >= 1) {
            f32x4 rv[4]; float ss = 0.f;
#pragma unroll
            for (int j = 0; j < 4; ++j) { rv[j] = ((const f32x4*)(RAW + (size_t)row * DM))[F.lane + 64 * j]; ss += rv[j].x * rv[j].x + rv[j].y * rv[j].y + rv[j].z * rv[j].z + rv[j].w * rv[j].w; }
            const float rstd = 1.0f / sqrtf(wave_sum(ss) * (1.0f / DM) + RMS_EPS);
            const float* gate = modl + (mode == 1 ? 2048 : 5120); const float* nga = ng + (mode == 1 ? 1024 : 3072);
#pragma unroll
            for (int j = 0; j < 4; ++j) { const f32x4 gv = ((const f32x4*)gate)[F.lane + 64 * j], nv = ((const f32x4*)nga)[F.lane + 64 * j]; xv[j] = xv[j] + gv * (rv[j] * rstd * nv); ((f32x4*)(X + (size_t)row * DM))[F.lane + 64 * j] = xv[j]; }
        }
        if (mode == 2 && l == 1) continue;
        const int ln = mode == 2 ? l + 1 : l;
        const float* modn = MOD + (size_t)(ln * 9 + pb) * 6144;
        const float* ngb = F.in[I_NORMG] + ln * 4096 + (mode == 1 ? 2048 : 0);
        const float* sc = modn + (mode == 1 ? 4096 : 1024); const float* sh = modn + (mode == 1 ? 3072 : 0);
        float ss = 0.f;
#pragma unroll
        for (int j = 0; j < 4; ++j) ss += xv[j].x * xv[j].x + xv[j].y * xv[j].y + xv[j].z * xv[j].z + xv[j].w * xv[j].w;
        const float rstd = 1.0f / sqrtf(wave_sum(ss) * (1.0f / DM) + RMS_EPS);
#pragma unroll
        for (int j = 0; j < 4; ++j) { const f32x4 nv = ((const f32x4*)ngb)[F.lane + 64 * j], sv = ((const f32x4*)sc)[F.lane + 64 * j], hv = ((const f32x4*)sh)[F.lane + 64 * j];
            const f32x4 o = xv[j] * rstd * nv * (sv + 1.0f) + hv; v2u w; w.x = pk2(o.x, o.y); w.y = pk2(o.z, o.w); ((v2u*)(XN + (size_t)row * DM))[F.lane + 64 * j] = w; }
    }
}

__device__ __forceinline__ float gelu_tanh(float x) { const float u = 0.7978845608028654f * (x + 0.044715f * x * x * x); return 0.5f * x * (1.0f + tanhf(u)); }
typedef float f32x16 __attribute__((ext_vector_type(16)));
typedef short bf16x8 __attribute__((ext_vector_type(8)));
typedef short bf16x4 __attribute__((ext_vector_type(4)));
#define MFMA32(a, b, c) __builtin_amdgcn_mfma_f32_32x32x16_bf16((a), (b), (c), 0, 0, 0)
typedef __bf16 bf16pair_t __attribute__((ext_vector_type(2)));
#define DOT2(a, b, c) __builtin_amdgcn_fdot2_f32_bf16(__builtin_bit_cast(bf16pair_t, (unsigned)(a)), __builtin_bit_cast(bf16pair_t, (unsigned)(b)), (c), false)
__device__ __forceinline__ unsigned cvtpk(float lo, float hi) { unsigned r; asm("v_cvt_pk_bf16_f32 %0, %1, %2" : "=v"(r) : "v"(lo), "v"(hi)); return r; }
__device__ __forceinline__ int crow(int r, int hh) { return (r & 3) + 8 * (r >> 2) + 4 * hh; }
__device__ __forceinline__ bf16x8 acc_frag(const f32x16& a, int s) {
    v4u w; w.x = cvtpk(a[8 * s + 0], a[8 * s + 1]); w.y = cvtpk(a[8 * s + 2], a[8 * s + 3]); w.z = cvtpk(a[8 * s + 4], a[8 * s + 5]); w.w = cvtpk(a[8 * s + 6], a[8 * s + 7]);
    return __builtin_bit_cast(bf16x8, w);
}
__device__ __forceinline__ bf16x8 cat4(bf16x4 a, bf16x4 b) { return __builtin_shufflevector(a, b, 0, 1, 2, 3, 4, 5, 6, 7); }

typedef float f32x4m __attribute__((ext_vector_type(4)));
constexpr int S5_HS = 272, S5_WB = 33 * S5_HS;
__device__ __forceinline__ float gelu_fast(float x) { const float u = 0.7978845608028654f * (x + 0.044715f * x * x * x); const float e = __expf(2.0f * u); return 0.5f * x * (2.0f - 2.0f / (1.0f + e)); }
__device__ __forceinline__ void s5_item(const Frame& F, int l, int item) {
    const int w = F.wave, lane = F.lane, hh = lane >> 5, c31 = lane & 31, l15 = lane & 15, l4 = lane >> 4, pair = item * 4 + (w >> 1), d = w & 1;
    const bool lat = pair < 256; const int pp = lat ? pair : pair - 256, b = pp >> 5, g = pp & 31;
    const int L = lat ? L_LAT : L_CTX, row0 = lat ? M_CTX + b * L_LAT : b * L_CTX, nch = L >> 5;
    const bf16* Z = (const bf16*)(F.ws + WS_Z); bf16* SS = (bf16*)(F.ws + WS_XN);
    unsigned char* Hb = F.lds + w * S5_WB;
    float ar[2], ai[2]; bf16x8 bfr[4], cfr[4]; float hr[2], hi[2];
#pragma unroll
    for (int q = 0; q < 2; ++q) {
        const int pidx = ((l * 2 + d) * 32 + g) * 64 + 32 * q + c31;
        const float lre = F.in[I_LRE][pidx], lim = F.in[I_LIM][pidx], dt = expf(F.in[I_LSTEP][pidx]);
        const float mag = expf(lre * dt); float sn, cs; sincosf(lim * dt, &sn, &cs);
        ar[q] = mag * cs; ai[q] = mag * sn; const float nr = ar[q] - 1.0f, ni = ai[q], den = lre * lre + lim * lim;
        const float fr = (nr * lre + ni * lim) / den, fi = (ni * lre - nr * lim) / den;
        const f32x4* brp = (const f32x4*)(F.in[I_BRE] + (size_t)pidx * 16 + 8 * hh); const f32x4* bip = (const f32x4*)(F.in[I_BIM] + (size_t)pidx * 16 + 8 * hh);
        const f32x4 br0 = brp[0], br1 = brp[1], bi0 = bip[0], bi1 = bip[1];
        v4u wr_, wi_;
        wr_.x = cvtpk(fr * br0[0] - fi * bi0[0], fr * br0[1] - fi * bi0[1]); wr_.y = cvtpk(fr * br0[2] - fi * bi0[2], fr * br0[3] - fi * bi0[3]); wr_.z = cvtpk(fr * br1[0] - fi * bi1[0], fr * br1[1] - fi * bi1[1]); wr_.w = cvtpk(fr * br1[2] - fi * bi1[2], fr * br1[3] - fi * bi1[3]);
        wi_.x = cvtpk(fr * bi0[0] + fi * br0[0], fr * bi0[1] + fi * br0[1]); wi_.y = cvtpk(fr * bi0[2] + fi * br0[2], fr * bi0[3] + fi * br0[3]); wi_.z = cvtpk(fr * bi1[0] + fi * br1[0], fr * bi1[1] + fi * br1[1]); wi_.w = cvtpk(fr * bi1[2] + fi * br1[2], fr * bi1[3] + fi * br1[3]);
        bfr[q] = __builtin_bit_cast(bf16x8, wr_); bfr[2 + q] = __builtin_bit_cast(bf16x8, wi_);
        hr[q] = 0.f; hi[q] = 0.f;
        if (lat) { const size_t si = ((size_t)((((b * 2 + l) * 2 + d) * 32 + g) * 64 + 32 * q + c31)) * 2; hr[q] = F.in[I_SS5][si]; hi[q] = F.in[I_SS5][si + 1]; }
    }
#pragma unroll
    for (int kk = 0; kk < 4; ++kk) {
        const size_t cb = ((size_t)(((l * 2 + d) * 32 + g) * 16 + l15)) * 64 + kk * 16 + 4 * l4;
        const f32x4 cr = *(const f32x4*)(F.in[I_CRE] + cb), ci = *(const f32x4*)(F.in[I_CIM] + cb);
        v4u wc_; wc_.x = cvtpk(cr[0], -ci[0]); wc_.y = cvtpk(cr[1], -ci[1]); wc_.z = cvtpk(cr[2], -ci[2]); wc_.w = cvtpk(cr[3], -ci[3]);
        cfr[kk] = __builtin_bit_cast(bf16x8, wc_);
    }
    const float dsk = F.in[I_S5D][l * 512 + g * 16 + l15];
    asm volatile("" ::: "memory");
    const f32x16 zero16 = {0.f, 0.f, 0.f, 0.f, 0.f, 0.f, 0.f, 0.f, 0.f, 0.f, 0.f, 0.f, 0.f, 0.f, 0.f, 0.f};
    bf16x8 unext = *(const bf16x8*)(Z + (size_t)(row0 + (d ? L - 1 - c31 : c31)) * ZP + g * 16 + 8 * hh);
    for (int c0 = 0; c0 < nch; ++c0) {
        int c = c0; asm volatile("" : "+s"(c));
        const bf16x8 uf = unext;
        if (c + 1 < nch) { const int tau = 32 * (c + 1) + c31; unext = *(const bf16x8*)(Z + (size_t)(row0 + (d ? L - 1 - tau : tau)) * ZP + g * 16 + 8 * hh); }
        const f32x16 bur0 = MFMA32(uf, bfr[0], zero16), bur1 = MFMA32(uf, bfr[1], zero16), bui0 = MFMA32(uf, bfr[2], zero16), bui1 = MFMA32(uf, bfr[3], zero16);
#pragma unroll
        for (int g8 = 0; g8 < 8; ++g8) {
            float r0 = hr[0], i0 = hi[0], r1 = hr[1], i1 = hi[1];
            unsigned char* hrow = (hh == (g8 & 1)) ? Hb + (4 * g8) * S5_HS : Hb + 32 * S5_HS - 0 * S5_HS;
            const int rstep = (hh == (g8 & 1)) ? S5_HS : 0;
#pragma unroll
            for (int i = 0; i < 4; ++i) { const int r = 4 * (g8 >> 1) + i;
                const float n0 = ar[0] * r0 - ai[0] * i0 + bur0[r], m0 = ar[0] * i0 + ai[0] * r0 + bui0[r]; r0 = n0; i0 = m0;
                const float n1 = ar[1] * r1 - ai[1] * i1 + bur1[r], m1 = ar[1] * i1 + ai[1] * r1 + bui1[r]; r1 = n1; i1 = m1;
                *(unsigned*)(hrow + i * rstep + c31 * 4) = cvtpk(r0, i0); *(unsigned*)(hrow + i * rstep + (32 + c31) * 4) = cvtpk(r1, i1); }
            { auto t = __builtin_amdgcn_permlane32_swap(__float_as_uint(r0), __float_as_uint(r0), false, false); hr[0] = __uint_as_float(t[g8 & 1]); }
            { auto t = __builtin_amdgcn_permlane32_swap(__float_as_uint(i0), __float_as_uint(i0), false, false); hi[0] = __uint_as_float(t[g8 & 1]); }
            { auto t = __builtin_amdgcn_permlane32_swap(__float_as_uint(r1), __float_as_uint(r1), false, false); hr[1] = __uint_as_float(t[g8 & 1]); }
            { auto t = __builtin_amdgcn_permlane32_swap(__float_as_uint(i1), __float_as_uint(i1), false, false); hi[1] = __uint_as_float(t[g8 & 1]); }
        }
        f32x4m y0 = {0.f, 0.f, 0.f, 0.f}, y1 = {0.f, 0.f, 0.f, 0.f};
#pragma unroll
        for (int kk = 0; kk < 4; ++kk) {
            y0 = __builtin_amdgcn_mfma_f32_16x16x32_bf16(*(const bf16x8*)(Hb + l15 * S5_HS + (kk * 32 + 8 * l4) * 2), cfr[kk], y0, 0, 0, 0);
            y1 = __builtin_amdgcn_mfma_f32_16x16x32_bf16(*(const bf16x8*)(Hb + (16 + l15) * S5_HS + (kk * 32 + 8 * l4) * 2), cfr[kk], y1, 0, 0, 0);
        }
        const bool fin = c >= (nch >> 1);
#pragma unroll
        for (int mt = 0; mt < 2; ++mt)
#pragma unroll
            for (int r = 0; r < 4; ++r) { const int tau = 32 * c + 16 * mt + 4 * l4 + r, t = d ? L - 1 - tau : tau; const size_t row = (size_t)(row0 + t);
                bf16* sp = SS + row * 512 + g * 16 + l15; float y = mt ? y1[r] : y0[r];
                if (fin) y = gelu_fast(y + bf2f(*sp) + dsk * bf2f(Z[row * ZP + g * 16 + l15]));
                *sp = (bf16)f2bf(y); }
        if (c == (nch >> 1) - 1) __syncthreads();
    }
    if (!lat && hh == 0) {
#pragma unroll
        for (int q = 0; q < 2; ++q) { float* so = F.out + O_S5 + ((size_t)((((b * 2 + l) * 2 + d) * 32 + g) * 64 + 32 * q + c31)) * 2; so[0] = hr[q]; so[1] = hi[q]; }
    }
    __syncthreads();
}
constexpr int GL_VS = 36, GL_QT = 0, GL_KT = 4608, GL_KTT = 9216, GL_VT = 14336, GL_EB = 24576, GL_BUF = 24832, GL_LR = 2 * GL_BUF, GL_DIR = 2 * GL_BUF + 8192;
static_assert(2 * GL_DIR <= RING_BYTES, "GLA LDS");
__device__ __forceinline__ void gla_item(const Frame& F, int l, int item) {
    const bool lat = item < 32; const int ii = lat ? item : item - 32, b = ii >> 2, h = ii & 3;
    const int L = lat ? L_LAT : L_CTX, row0 = lat ? M_CTX + b * L_LAT : b * L_CTX, nch = L >> 5;
    const int d = F.wave >> 2, sl = F.wave & 3, lane = F.lane, hh = lane >> 5, c31 = lane & 31;
    const bf16* Z = (const bf16*)(F.ws + WS_Z); bf16* GS = (bf16*)(F.ws + WS_GS);
    unsigned char* ldd = F.lds + d * GL_DIR;
    const int dka = sl * 16 + (lane & 15), tg = lane >> 4;
    unsigned wgp[8];
#pragma unroll
    for (int r = 0; r < 8; ++r) wgp[r] = cvtpk(F.in[I_WGK][((size_t)((l * 2 + d) * 16 + 2 * r)) * 256 + h * 64 + dka], F.in[I_WGK][((size_t)((l * 2 + d) * 16 + 2 * r + 1)) * 256 + h * 64 + dka]);
    const float bg = F.in[I_BGK][(l * 2 + d) * 256 + h * 64 + dka];
    const int dt = sl * 64 + lane;
    f32x16 S0, S1;
#pragma unroll
    for (int r = 0; r < 16; ++r) {
        const size_t sb = ((size_t)((((b * 2 + l) * 2 + d) * 4 + h) * 64)) * 128 + sl * 32 + c31;
        const float* sp = F.in[I_SGLA] + (lat ? sb : (size_t)0); const float lm = lat ? 1.f : 0.f;
        S0[r] = sp[(size_t)crow(r, hh) * 128] * lm; S1[r] = sp[(size_t)(32 + crow(r, hh)) * 128] * lm; }
    asm volatile("" ::: "memory");
#define GLA_LR_LOAD(kb, r0_, r1_) do { const int tau = 256 * (kb) + dt, t = d ? L - 1 - tau : tau; const bf16* zr = Z + (size_t)(row0 + t) * ZP + 2816 + d * 16; r0_ = *(const v4u*)zr; r1_ = *(const v4u*)(zr + 8); } while (0)
#define GLA_LR_WRITE(r0_, r1_) do { *(v4u*)(ldd + GL_LR + dt * 32) = r0_; *(v4u*)(ldd + GL_LR + dt * 32 + 16) = r1_; } while (0)
#define GLA_IN_LOAD(c, qk_, vv_) do { \
        _Pragma("unroll") for (int e = 0; e < 8; ++e) { const int tau = 32 * (c) + 8 * tg + e, t = d ? L - 1 - tau : tau; const bf16* zr = Z + (size_t)(row0 + t) * ZP; \
            qk_[e] = (unsigned)zr[512 + h * 64 + dka] | ((unsigned)zr[768 + h * 64 + dka] << 16); } \
        _Pragma("unroll") for (int k2 = 0; k2 < 2; ++k2) { const int rho = (lane & 15) + 16 * k2, sg = (lane >> 4) + 4 * sl, tau = 32 * (c) + rho, t = d ? L - 1 - tau : tau; \
            vv_[k2] = *(const v4u*)(Z + (size_t)(row0 + t) * ZP + 1024 + h * 128 + sg * 8); } } while (0)
#define GLA_STEP_A(c, qk_, vv_) do { unsigned char* bufp = ldd + ((c) & 1) * GL_BUF; \
        float gk[8]; \
        _Pragma("unroll") for (int e = 0; e < 8; ++e) { const unsigned char* lrp = ldd + GL_LR + (32 * ((c) & 7) + 8 * tg + e) * 32; const v4u a0 = *(const v4u*)lrp, a1 = *(const v4u*)(lrp + 16); \
            float x = DOT2(a0.x, wgp[0], bg); x = DOT2(a0.y, wgp[1], x); x = DOT2(a0.z, wgp[2], x); x = DOT2(a0.w, wgp[3], x); x = DOT2(a1.x, wgp[4], x); x = DOT2(a1.y, wgp[5], x); x = DOT2(a1.z, wgp[6], x); x = DOT2(a1.w, wgp[7], x); \
            gk[e] = (fminf(x, 0.f) - __logf(1.0f + __expf(-fabsf(x)))) * 0.0625f; } \
        _Pragma("unroll") for (int e = 1; e < 8; ++e) gk[e] += gk[e - 1]; \
        { const float tot = gk[7]; float p1 = __shfl_up(tot, 16), p2 = __shfl_up(tot, 32), p3 = __shfl_up(tot, 48); const float pre = (tg >= 1 ? p1 : 0.f) + (tg >= 2 ? p2 : 0.f) + (tg >= 3 ? p3 : 0.f); \
          _Pragma("unroll") for (int e = 0; e < 8; ++e) gk[e] += pre; } \
        unsigned kt8[4]; \
        _Pragma("unroll") for (int e = 0; e < 8; ++e) { const int rho = 8 * tg + e; const float ep = __expf(gk[e]), em = __builtin_amdgcn_rcpf(ep); const float qv = bflo(qk_[e]) * ep, kv = bfhi(qk_[e]) * em; \
            const unsigned pq = cvtpk(qv, kv); ((bf16*)(bufp + GL_QT))[rho * 72 + dka] = (bf16)(pq & 0xffff); ((bf16*)(bufp + GL_KT))[rho * 72 + dka] = (bf16)(pq >> 16); \
            if (e & 1) kt8[e >> 1] |= pq & 0xffff0000u; else kt8[e >> 1] = pq >> 16; } \
        *(v4u*)(bufp + GL_KTT + dka * 80 + tg * 16) = (v4u){kt8[0], kt8[1], kt8[2], kt8[3]}; \
        if (tg == 3) ((float*)(bufp + GL_EB))[dka] = __expf(gk[7]); \
        _Pragma("unroll") for (int k2 = 0; k2 < 2; ++k2) { const int rho = (lane & 15) + 16 * k2, sg = (lane >> 4) + 4 * sl; const v4u vv = vv_[k2]; bf16* vt = (bf16*)(bufp + GL_VT) + (sg * 8) * GL_VS + rho; \
            vt[0] = (bf16)(vv.x & 0xffff); vt[GL_VS] = (bf16)(vv.x >> 16); vt[2 * GL_VS] = (bf16)(vv.y & 0xffff); vt[3 * GL_VS] = (bf16)(vv.y >> 16); vt[4 * GL_VS] = (bf16)(vv.z & 0xffff); vt[5 * GL_VS] = (bf16)(vv.z >> 16); vt[6 * GL_VS] = (bf16)(vv.w & 0xffff); vt[7 * GL_VS] = (bf16)(vv.w >> 16); } \
    } while (0)
    unsigned qk[8]; v4u vv2[2]; v4u lr0 = {0u, 0u, 0u, 0u}, lr1 = lr0;
    { int cz = 0; asm volatile("" : "+s"(cz)); GLA_LR_LOAD(cz, lr0, lr1); GLA_LR_WRITE(lr0, lr1); GLA_IN_LOAD(cz, qk, vv2); __syncthreads(); GLA_STEP_A(cz, qk, vv2); }
    __syncthreads();
    for (int c0 = 0; c0 < nch; ++c0) {
        int c = c0; asm volatile("" : "+s"(c));
        const bool more = c + 1 < nch;
        if (more) GLA_IN_LOAD(c + 1, qk, vv2);
        if (more && ((c + 1) & 7) == 7 && c + 2 < nch) GLA_LR_LOAD((c + 2) >> 3, lr0, lr1);
        const unsigned char* bufp = ldd + (c & 1) * GL_BUF;
        const bf16* QT = (const bf16*)(bufp + GL_QT); const bf16* KT = (const bf16*)(bufp + GL_KT); const bf16* KTT = (const bf16*)(bufp + GL_KTT); const bf16* VT = (const bf16*)(bufp + GL_VT); const float* EB = (const float*)(bufp + GL_EB);
        f32x16 at = {0.f, 0.f, 0.f, 0.f, 0.f, 0.f, 0.f, 0.f, 0.f, 0.f, 0.f, 0.f, 0.f, 0.f, 0.f, 0.f};
#pragma unroll
        for (int s = 0; s < 4; ++s) at = MFMA32(*(const bf16x8*)(KT + c31 * 72 + 16 * s + 8 * hh), *(const bf16x8*)(QT + c31 * 72 + 16 * s + 8 * hh), at);
#pragma unroll
        for (int r = 0; r < 16; ++r) if (crow(r, hh) > c31) at[r] = 0.f;
        f32x16 o = {0.f, 0.f, 0.f, 0.f, 0.f, 0.f, 0.f, 0.f, 0.f, 0.f, 0.f, 0.f, 0.f, 0.f, 0.f, 0.f};
#pragma unroll
        for (int s = 0; s < 2; ++s) {
            o = MFMA32(cat4(*(const bf16x4*)(QT + c31 * 72 + 16 * s + 4 * hh), *(const bf16x4*)(QT + c31 * 72 + 16 * s + 8 + 4 * hh)), acc_frag(S0, s), o);
            o = MFMA32(cat4(*(const bf16x4*)(QT + c31 * 72 + 32 + 16 * s + 4 * hh), *(const bf16x4*)(QT + c31 * 72 + 32 + 16 * s + 8 + 4 * hh)), acc_frag(S1, s), o);
        }
        const bf16* vtr = VT + (sl * 32 + c31) * GL_VS;
#pragma unroll
        for (int s = 0; s < 2; ++s) o = MFMA32(acc_frag(at, s), cat4(*(const bf16x4*)(vtr + 16 * s + 4 * hh), *(const bf16x4*)(vtr + 16 * s + 8 + 4 * hh)), o);
#pragma unroll
        for (int r = 0; r < 16; r += 2) { const unsigned po = cvtpk(o[r], o[r + 1]); const int tau = 32 * c + crow(r, hh), t = d ? L - 1 - tau : tau, t1 = d ? t - 1 : t + 1;
            bf16* gp = GS + (size_t)d * M_TOK * 512 + h * 128 + sl * 32 + c31; gp[(size_t)(row0 + t) * 512] = (bf16)(po & 0xffff); gp[(size_t)(row0 + t1) * 512] = (bf16)(po >> 16); }
#pragma unroll
        for (int s = 0; s < 2; ++s) { const bf16x8 vb = cat4(*(const bf16x4*)(vtr + 16 * s + 8 * hh), *(const bf16x4*)(vtr + 16 * s + 8 * hh + 4));
            S0 = MFMA32(*(const bf16x8*)(KTT + c31 * 40 + 16 * s + 8 * hh), vb, S0); S1 = MFMA32(*(const bf16x8*)(KTT + (32 + c31) * 40 + 16 * s + 8 * hh), vb, S1); }
#pragma unroll
        for (int g4 = 0; g4 < 4; ++g4) { const f32x4 e0 = *(const f32x4*)(EB + 8 * g4 + 4 * hh), e1 = *(const f32x4*)(EB + 32 + 8 * g4 + 4 * hh);
#pragma unroll
            for (int i = 0; i < 4; ++i) { S0[4 * g4 + i] *= e0[i]; S1[4 * g4 + i] *= e1[i]; } }
        if (more) {
            if (((c + 1) & 7) == 0) { GLA_LR_WRITE(lr0, lr1); __syncthreads(); }
            GLA_STEP_A(c + 1, qk, vv2);
        }
        __syncthreads();
    }
#undef GLA_STEP_A
#undef GLA_IN_LOAD
#undef GLA_LR_LOAD
#undef GLA_LR_WRITE
    if (!lat) {
#pragma unroll
        for (int r = 0; r < 16; ++r) { float* so = F.out + O_GLA + ((size_t)((((b * 2 + l) * 2 + d) * 4 + h) * 64)) * 128 + sl * 32 + c31;
            so[(size_t)crow(r, hh) * 128] = S0[r]; so[(size_t)(32 + crow(r, hh)) * 128] = S1[r]; }
    }
    __syncthreads();
}
__device__ __forceinline__ void gla_combine_rows(const Frame& F, int l) {
    const bf16* Z = (const bf16*)(F.ws + WS_Z); const bf16* GS = (const bf16*)(F.ws + WS_GS); bf16* YB = (bf16*)(F.ws + WS_Y);
    const int gw = F.bid * NWAVES + F.wave, NGW = F.G * NWAVES;
    const float* gn = F.in[I_GNG] + l * 128 + 2 * F.lane; const float gn0 = gn[0], gn1 = gn[1];
    for (int u0 = gw * 4; u0 < M_TOK * 4; u0 += NGW * 4) {
        unsigned a[4], bb[4], gg[4];
#pragma unroll
        for (int k = 0; k < 4; ++k) { const int u = u0 + k; const size_t row = (size_t)(u >> 2); const int c = (u & 3) * 128 + 2 * F.lane;
            a[k] = *(const unsigned*)(GS + row * 512 + c); bb[k] = *(const unsigned*)(GS + (size_t)M_TOK * 512 + row * 512 + c); gg[k] = *(const unsigned*)(Z + row * ZP + 1536 + c); }
#pragma unroll
        for (int k = 0; k < 4; ++k) { const int u = u0 + k; const size_t row = (size_t)(u >> 2); const int c = (u & 3) * 128 + 2 * F.lane;
            const float o0 = bflo(a[k]) + bflo(bb[k]), o1 = bfhi(a[k]) + bfhi(bb[k]);
            const float rstd = 1.0f / sqrtf(wave_sum(o0 * o0 + o1 * o1) * (1.0f / 128.0f) + RMS_EPS);
            const float g0 = bflo(gg[k]), g1 = bfhi(gg[k]);
            *(unsigned*)(YB + row * 512 + c) = pk2(o0 * rstd * gn0 * (g0 / (1.0f + __expf(-g0))), o1 * rstd * gn1 * (g1 / (1.0f + __expf(-g1)))); }
    }
}
constexpr int AT_K = 0, AT_VT = 4608, AT_BUF = 9728;
__device__ __forceinline__ void attn_item(const Frame& F, int l, int item) {
    const bool lat = item < 256; const int ii = lat ? item : item - 256;
    const int b = lat ? ii >> 5 : ii >> 3, kvh = lat ? (ii >> 4) & 1 : (ii >> 2) & 1, qt = lat ? ii & 15 : ii & 3;
    const int L = lat ? L_LAT : L_CTX, row0 = lat ? M_CTX + b * L_LAT : b * L_CTX, q0 = qt * 64;
    const int w = F.wave, lane = F.lane, hh = lane >> 5, c31 = lane & 31, hq = kvh * 4 + (w >> 1), tq = q0 + 32 * (w & 1) + c31;
    const bf16* Z = (const bf16*)(F.ws + WS_Z); bf16* YC = (bf16*)(F.ws + WS_Y) + (size_t)M_TOK * 512;
    const bf16* ck = (const bf16*)(F.ws + WS_CKV) + (size_t)((l * 8 + b) * 256) * 128 + kvh * 64; const bf16* cv = ck + 524288;
    const int j0 = lat ? (q0 - 128 < 0 ? 0 : q0 - 128) : 0, j1 = lat ? (q0 + 192 > L ? L : q0 + 192) : L;
    const int nw = (j1 - j0) >> 5, nt = lat ? nw + 8 : nw;
    bf16x8 qf[4];
    { const bf16* qp = Z + (size_t)(row0 + tq) * ZP + 2048 + hq * 64 + 8 * hh;
#pragma unroll
      for (int s = 0; s < 4; ++s) qf[s] = *(const bf16x8*)(qp + 16 * s); }
    f32x16 O0 = {0.f, 0.f, 0.f, 0.f, 0.f, 0.f, 0.f, 0.f, 0.f, 0.f, 0.f, 0.f, 0.f, 0.f, 0.f, 0.f}, O1 = O0;
    float m = F.in[I_SINK][l * 8 + hq], ls = 1.0f;
    const int st = (w & 3) * 64 + lane, skey = (st & 15) + 16 * ((st >> 4) & 1), sseg = st >> 5; const bool isk = w < 4;
#define AT_SRC(kt) ((kt) < nw ? Z + (size_t)(row0 + j0 + 32 * (kt) + skey) * ZP + (isk ? 2560 : 2688) + kvh * 64 + sseg * 8 : (isk ? ck : cv) + (size_t)(32 * ((kt) - nw) + skey) * 128 + sseg * 8)
#define AT_WRITE(kt, val) do { unsigned char* bp = F.lds + ((kt) & 1) * AT_BUF; \
        if (isk) *(v4u*)(bp + AT_K + skey * 144 + sseg * 16) = (val); \
        else { bf16* vt = (bf16*)(bp + AT_VT) + (sseg * 8) * 36 + skey; vt[0] = (bf16)((val).x & 0xffff); vt[36] = (bf16)((val).x >> 16); vt[72] = (bf16)((val).y & 0xffff); vt[108] = (bf16)((val).y >> 16); \
               vt[144] = (bf16)((val).z & 0xffff); vt[180] = (bf16)((val).z >> 16); vt[216] = (bf16)((val).w & 0xffff); vt[252] = (bf16)((val).w >> 16); } } while (0)
    { const v4u v0 = *(const v4u*)AT_SRC(0); AT_WRITE(0, v0); }
    __syncthreads();
    for (int kt0 = 0; kt0 < nt; ++kt0) {
        int kt = kt0; asm volatile("" : "+s"(kt));
        v4u pre = {0u, 0u, 0u, 0u}; if (kt + 1 < nt) pre = *(const v4u*)AT_SRC(kt + 1);
        const unsigned char* bp = F.lds + (kt & 1) * AT_BUF; const bf16* KT = (const bf16*)(bp + AT_K); const bf16* VT = (const bf16*)(bp + AT_VT);
        f32x16 sc = {0.f, 0.f, 0.f, 0.f, 0.f, 0.f, 0.f, 0.f, 0.f, 0.f, 0.f, 0.f, 0.f, 0.f, 0.f, 0.f};
#pragma unroll
        for (int s = 0; s < 4; ++s) sc = MFMA32(*(const bf16x8*)(KT + c31 * 72 + 16 * s + 8 * hh), qf[s], sc);
        if (lat && kt < nw) { const int jb = j0 + 32 * kt - tq;
#pragma unroll
            for (int r = 0; r < 16; ++r) { const int dj = jb + crow(r, hh); if (dj > 128 || dj < -128) sc[r] = -INFINITY; } }
        float mx = sc[0];
#pragma unroll
        for (int r = 1; r < 16; ++r) mx = fmaxf(mx, sc[r]);
        mx = fmaxf(mx, __shfl_xor(mx, 32));
        const float mn = fmaxf(m, mx), al = __expf(m - mn); m = mn;
        float ps = 0.f;
#pragma unroll
        for (int r = 0; r < 16; ++r) { sc[r] = __expf(sc[r] - mn); ps += sc[r]; }
        ps += __shfl_xor(ps, 32); ls = ls * al + ps;
#pragma unroll
        for (int r = 0; r < 16; ++r) { O0[r] *= al; O1[r] *= al; }
#pragma unroll
        for (int s = 0; s < 2; ++s) { const bf16x8 pf = acc_frag(sc, s);
            O0 = MFMA32(cat4(*(const bf16x4*)(VT + c31 * 36 + 16 * s + 4 * hh), *(const bf16x4*)(VT + c31 * 36 + 16 * s + 8 + 4 * hh)), pf, O0);
            O1 = MFMA32(cat4(*(const bf16x4*)(VT + (32 + c31) * 36 + 16 * s + 4 * hh), *(const bf16x4*)(VT + (32 + c31) * 36 + 16 * s + 8 + 4 * hh)), pf, O1); }
        if (kt + 1 < nt) AT_WRITE(kt + 1, pre);
        __syncthreads();
    }
#undef AT_SRC
#undef AT_WRITE
    const float inv = 1.0f / ls;
    bf16* op = YC + (size_t)(row0 + tq) * 512 + hq * 64 + 4 * hh;
#pragma unroll
    for (int g = 0; g < 4; ++g) {
        v2u w0; w0.x = cvtpk(O0[4 * g] * inv, O0[4 * g + 1] * inv); w0.y = cvtpk(O0[4 * g + 2] * inv, O0[4 * g + 3] * inv); *(v2u*)(op + 8 * g) = w0;
        v2u w1; w1.x = cvtpk(O1[4 * g] * inv, O1[4 * g + 1] * inv); w1.y = cvtpk(O1[4 * g + 2] * inv, O1[4 * g + 3] * inv); *(v2u*)(op + 32 + 8 * g) = w1; }
}
__device__ __forceinline__ void mixer_phase(const Frame& F, int l) {
    unsigned* qhead = (unsigned*)(F.ws + WS_CTL) + 64 * (1 + l);
    volatile unsigned* slot = (volatile unsigned*)(F.lds + MISC_OFF) + 12;
    for (;;) {
        if (F.tid == 0) *slot = __hip_atomic_fetch_add(qhead, 1u, __ATOMIC_RELAXED, __HIP_MEMORY_SCOPE_AGENT);
        __syncthreads();
        int it = __builtin_amdgcn_readfirstlane((int)*slot);
        if (it >= 672) break;
        int kind, idx;
        if (it < 32) { kind = 1; idx = it; } else if (it < 96) { kind = 0; idx = it - 32; } else if (it < 352) { kind = 2; idx = it - 96; }
        else if (it < 416) { kind = 1; idx = it - 352 + 32; } else if (it < 544) { kind = 0; idx = it - 416 + 64; } else { kind = 2; idx = it - 544 + 256; }
        Frame G = F;
        { int tid = F.tid; asm volatile("" : "+v"(tid)); asm volatile("" : "+s"(idx)); G.tid = tid; G.lane = tid & 63; G.wave = __builtin_amdgcn_readfirstlane(tid >> 6); }
        if (kind == 0) s5_item(G, l, idx);
        else if (kind == 1) gla_item(G, l, idx);
        else attn_item(G, l, idx);
    }
    __syncthreads();
}

constexpr int N_PHASES = 20;
__global__ void __launch_bounds__(NWAVES * 64, 2) fwd_kernel(Args args) {
    extern __shared__ __attribute__((aligned(16))) unsigned char lds[];
    Frame F;
    F.lds = lds; F.tid = threadIdx.x; F.lane = F.tid & 63; F.wave = __builtin_amdgcn_readfirstlane(F.tid >> 6); F.G = gridDim.x; F.bid = blockIdx.x;
    F.in = (kargs_t)__builtin_amdgcn_kernarg_segment_ptr();
    F.out = (float*)F.in[N_IN]; F.ws = (unsigned char*)F.in[N_IN + 1];
    LAS unsigned char* llds = (LAS unsigned char*)lds;
    for (int u = F.tid; u < (LDS_BYTES - LDSCTL_OFF) / 4; u += NWAVES * 64) ((LAS unsigned*)(llds + LDSCTL_OFF))[u] = 0u;
    __syncthreads();
    XcdBarrier bar; bar.bar = (unsigned*)(F.ws + WS_CTL) + CW_BAR; bar.x = 0; bar.st = nullptr;
    const int ph_lo = args.ph_lo, ph_hi = args.ph_hi;
    if (ph_hi - ph_lo > 1) bar = xcd_barrier_post((unsigned*)(F.ws + WS_CTL) + CW_BAR, (volatile LAS unsigned*)(llds + MISC_OFF) + 8);
    for (int ph = ph_lo; ph < ph_hi; ++ph) {
        { kargs_t kp = (kargs_t)__builtin_amdgcn_kernarg_segment_ptr(); asm volatile("" : "+s"(kp)); F.in = kp; F.out = (float*)kp[N_IN]; F.ws = (unsigned char*)kp[N_IN + 1]; }
        { int tid = threadIdx.x; asm volatile("" : "+v"(tid)); int bid = blockIdx.x; asm volatile("" : "+s"(bid));
          F.tid = tid; F.lane = tid & 63; F.wave = __builtin_amdgcn_readfirstlane(tid >> 6); F.bid = bid; }
        unsigned char* ws = F.ws;
        bf16* WT = (bf16*)(ws + WS_W);
        if (ph == 0) p0_prologue(F);
        else if (ph == 1) norm_phase(F, 0, 0);
        else {
            const int l = (ph - 2) / 9, s = (ph - 2) % 9;
            if (s == 0) {
                pg8::Gemm g{(const bf16*)(ws + WS_XN), WT + WO_IN, M_TOK, NZ, 1024, nullptr, nullptr}; pg8::StaticOrder S; S.init(M_TOK, NZ, F.G, F.bid);
                pg8::EpiWin E{(bf16*)(ws + WS_Z), (bf16*)(ws + WS_G), F.out + O_CK + l * 32768, F.out + O_CV + l * 32768, (const float*)(ws + WS_ROPE)};
                pg8::gemm_phase<pg8::EpiWin, pg8::StaticOrder, true>(llds + RING_OFF, g, S, E, F.tid);
            } else if (s == 1) {
                mixer_phase(F, l);
            } else if (s == 2) {
                gla_combine_rows(F, l);
                pg8::Gemm g{(const bf16*)(ws + WS_XN), WT + WO_GLU, M_TOK, 1024, 512, nullptr, nullptr}; pg8::StaticOrder S; S.init(M_TOK, 1024, F.G, F.bid);
                pg8::EpiGlu<0> E{(bf16*)(ws + WS_XN) + (size_t)M_TOK * 512, 512};
                pg8::gemm_phase<pg8::EpiGlu<0>, pg8::StaticOrder, true>(llds + RING_OFF, g, S, E, F.tid);
            } else if (s == 3) {
                pg8::Gemm g{(const bf16*)(ws + WS_XN) + (size_t)M_TOK * 512, WT + WO_BR, M_TOK, 1024, 512, (const bf16*)(ws + WS_Y), (const bf16*)(ws + WS_Y) + (size_t)M_TOK * 512};
                pg8::BranchOrder S; S.init(M_TOK, 1024, F.G, F.bid);
                pg8::EpiBranch E{(const bf16*)(ws + WS_G), (float*)(ws + WS_Z), (bf16*)(ws + WS_GS)};
                pg8::gemm_phase<pg8::EpiBranch, pg8::BranchOrder, true>(llds + RING_OFF, g, S, E, F.tid);
            } else if (s == 4) {
                pg8::Gemm g{(const bf16*)(ws + WS_GS), WT + WO_OUT, M_TOK, 1024, 1024, nullptr, nullptr}; pg8::StaticOrder S; S.init(M_TOK, 1024, F.G, F.bid);
                pg8::EpiF32 E{(float*)(ws + WS_Z), 1024};
                pg8::gemm_phase<pg8::EpiF32, pg8::StaticOrder, true>(llds + RING_OFF, g, S, E, F.tid);
            } else if (s == 5) {
                norm_phase(F, l, 1);
            } else if (s == 6) {
                pg8::Gemm g{(const bf16*)(ws + WS_XN), WT + WO_W1, M_TOK, FF2, 1024, nullptr, nullptr}; pg8::StaticOrder S; S.init(M_TOK, FF2, F.G, F.bid);
                pg8::EpiGlu<1> E{(bf16*)(ws + WS_G), FFH};
                pg8::gemm_phase<pg8::EpiGlu<1>, pg8::StaticOrder, true>(llds + RING_OFF, g, S, E, F.tid);
            } else if (s == 7) {
                pg8::Gemm g{(const bf16*)(ws + WS_G), WT + WO_W2, M_TOK, 1024, FFH, nullptr, nullptr}; pg8::StaticOrder S; S.init(M_TOK, 1024, F.G, F.bid);
                pg8::EpiF32 E{(float*)(ws + WS_Z), 1024};
                pg8::gemm_phase<pg8::EpiF32, pg8::StaticOrder, true>(llds + RING_OFF, g, S, E, F.tid);
            } else {
                norm_phase(F, l, 2);
                if (l == 0) convert_weights(F, 1);
            }
        }
        if (ph + 1 < ph_hi) xcd_barrier(bar);
    }
}

extern "C" void kernel_launch(void* const* d_in, const int* in_sizes, int n_in, void* d_out, int out_size, void* d_ws, size_t ws_size, hipStream_t stream) {
    static int grid = 0;
    if (grid == 0) {
        if (n_in != N_IN || out_size != (int)O_END || ws_size < WS_END) fprintf(stderr, "kernel_launch: unexpected shapes: n_in %d out %d ws %zu\n", n_in, out_size, ws_size);
        int dev = 0, cus = 0, per_cu = 0;
        if (hipGetDevice(&dev) != hipSuccess || hipDeviceGetAttribute(&cus, hipDeviceAttributeMultiprocessorCount, dev) != hipSuccess || cus <= 0) cus = 256;
        if (hipFuncSetAttribute((const void*)fwd_kernel, hipFuncAttributeMaxDynamicSharedMemorySize, LDS_BYTES) != hipSuccess) fprintf(stderr, "kernel_launch: hipFuncSetAttribute failed\n");
        if (hipOccupancyMaxActiveBlocksPerMultiprocessor(&per_cu, (const void*)fwd_kernel, NWAVES * 64, LDS_BYTES) != hipSuccess || per_cu < 1) fprintf(stderr, "kernel_launch: occupancy query reports %d workgroups per CU\n", per_cu);
        (void)hipGetLastError();
        grid = cus;
    }
    (void)hipMemsetAsync((char*)d_ws + WS_CTL, 0, CTL_ZERO_BYTES, stream);
    Args a{};
    for (int i = 0; i < N_IN; ++i) a.in[i] = (const float*)d_in[i];
    a.out = (float*)d_out; a.ws = (unsigned char*)d_ws;
#if MK_PER_PHASE
    for (int ph = 0; ph < N_PHASES; ++ph) { a.ph_lo = ph; a.ph_hi = ph + 1; hipLaunchKernelGGL(fwd_kernel, dim3(grid), dim3(NWAVES * 64), LDS_BYTES, stream, a); }
#else
    a.ph_lo = 0; a.ph_hi = N_PHASES;
    hipLaunchKernelGGL(fwd_kernel, dim3(grid), dim3(NWAVES * 64), LDS_BYTES, stream, a);
#endif
}
```

```cpp
#include <hip/hip_runtime.h>
#include <cstdio>
#include <cstdint>

#ifndef MK_PER_PHASE
#define MK_PER_PHASE 0
#endif

namespace pg8 {
#define PG8_LAS __attribute__((address_space(3)))
typedef unsigned short bf16_t;
typedef short bf16x8 __attribute__((ext_vector_type(8)));
typedef float f32x4 __attribute__((ext_vector_type(4)));
typedef float f32x2 __attribute__((ext_vector_type(2)));
typedef unsigned u32x4 __attribute__((ext_vector_type(4)));
typedef unsigned u32x2 __attribute__((ext_vector_type(2)));
constexpr int BM = 256, BK = 64, HALF = 128, HTB = HALF * BK * 2  , STAGE_BYTES = 8 * HTB, NXCD = 8, WGM = 8;

__host__ __device__ __forceinline__ int lds_byte(int r, int c) { const int st = (r >> 4) * 2 + (c >> 5), rr = r & 15, cc = c & 31, ob = rr * 64 + cc * 2; return st * 1024 + (ob ^ (((ob >> 9) & 1) << 5)); }
__host__ __device__ __forceinline__ void stage_rc(int b, int& R, int& C) { const int st = b / 1024, sb = b % 1024, swz = sb ^ (((sb >> 9) & 1) << 5); R = (st >> 1) * 16 + swz / 64; C = (st & 1) * 32 + (swz % 64) / 2; }
__host__ __device__ __forceinline__ int perm32(int rho) { const int n = rho >> 4, i = rho & 15; return 8 * (i >> 2) + 4 * n + (i & 3); }

struct Unit { int pm, pn, sel; };
struct Gemm { const bf16_t* A; const bf16_t* Bt; int M, N, K; const bf16_t* A1; const bf16_t* A2; };

struct StaticOrder {
    int nM, nN, nwg, G, c;
    __host__ __device__ void init(int M, int N, int G_, int c_) { nM = M / BM; nN = N / BM; nwg = nM * nN; G = G_; c = c_; }
    __host__ __device__ bool next(int i, Unit& u) const {
        const long L = (long)i * G + c; if (L >= nwg) return false;
        int wgid = (int)L; { const int q = nwg / NXCD, r = nwg % NXCD, xcd = wgid % NXCD, off = wgid / NXCD; wgid = (xcd < r ? xcd * (q + 1) : r * (q + 1) + (xcd - r) * q) + off; }
        const int nig = WGM * nN, gid = wgid / nig, fm = gid * WGM, gsz = (nM - fm) < WGM ? (nM - fm) : WGM;
        u.pm = fm + ((wgid % nig) % gsz); u.pn = (wgid % nig) / gsz; u.sel = 0; return true;
    }
    __device__ __forceinline__ const char* a_base(const Gemm& g, const Unit& u, size_t tstep) const { return (const char*)g.A + (size_t)u.pm * tstep; }
    __device__ __forceinline__ const char* b_base(const Gemm& g, const Unit& u, size_t tstep) const { return (const char*)g.Bt + (size_t)u.pn * tstep; }
};
struct BranchOrder {
    StaticOrder so;
    __host__ __device__ void init(int M, int N, int G_, int c_) { so.init(M, N, G_, c_); }
    __host__ __device__ bool next(int i, Unit& u) const { if (i >= 3) return false; if (!so.next(0, u)) return false; u.sel = i; return true; }
    __device__ __forceinline__ const char* a_base(const Gemm& g, const Unit& u, size_t tstep) const { const bf16_t* a = u.sel == 0 ? g.A : (u.sel == 1 ? g.A1 : g.A2); return (const char*)a + (size_t)u.pm * tstep; }
    __device__ __forceinline__ const char* b_base(const Gemm& g, const Unit& u, size_t tstep) const { return (const char*)g.Bt + (size_t)(u.sel * so.nN + u.pn) * tstep; }
};

__device__ __forceinline__ unsigned cvt_pk_bf16(float lo, float hi) { unsigned r; asm volatile("v_cvt_pk_bf16_f32 %0, %1, %2" : "=v"(r) : "v"(lo), "v"(hi)); return r; }
__device__ __forceinline__ float bf_lo(unsigned w) { return __builtin_bit_cast(float, w << 16); }
__device__ __forceinline__ float bf_hi(unsigned w) { return __builtin_bit_cast(float, w & 0xffff0000u); }
__device__ __forceinline__ float sigmoidf_(float x) { return 1.0f / (1.0f + __expf(-x)); }


struct EpiWin {
    static constexpr bool PERM = false, AFTER_DRAIN = false;
    bf16_t* Z; bf16_t* G; float* outk; float* outv; const float* rope;
    __device__ __forceinline__ void operator()(const f32x4 (&acc)[2][2][4][2], const Unit& u, int wr, int wc, int fr, int fq) const {
        const bool lat = u.pm >= 16;
        int rowb = u.pm * BM + wr * 64 + fr; asm volatile("" : "+v"(rowb));
#pragma unroll
        for (int bj = 0; bj < 2; ++bj) {
            const int c32 = u.pn * BM + bj * HALF + wc * 32;
            if (c32 >= 3072) {
#pragma unroll
                for (int ai = 0; ai < 2; ++ai)
#pragma unroll
                    for (int m = 0; m < 4; ++m) { bf16_t* gp = G + (size_t)(rowb + ai * HALF + m * 16) * 3072 + (c32 - 3072) + 4 * fq;
#pragma unroll
                        for (int n = 0; n < 2; ++n) { const f32x4 v = acc[ai][bj][m][n]; u32x2 w; w.x = cvt_pk_bf16(sigmoidf_(v[0]), sigmoidf_(v[1])); w.y = cvt_pk_bf16(sigmoidf_(v[2]), sigmoidf_(v[3])); *(u32x2*)(gp + 16 * n) = w; } }
            } else if (c32 >= 2848) {
            } else if (lat && c32 >= 2048 && c32 < 2688) {
                const float sc = c32 < 2560 ? 0.125f : 1.0f;
#pragma unroll
                for (int ai = 0; ai < 2; ++ai)
#pragma unroll
                    for (int m = 0; m < 4; ++m) { const int row = rowb + ai * HALF + m * 16, t = (row - 4096) & 1023, pos = (c32 & 32) ? (t & 63) : (t >> 6);
                        const f32x4* rp = (const f32x4*)(rope + (pos * 16 + 4 * fq) * 2); const f32x4 r0 = rp[0], r1 = rp[1];
                        const f32x4 x1 = acc[ai][bj][m][0] * sc, x2 = acc[ai][bj][m][1] * sc;
                        const f32x4 cs = (f32x4){r0[0], r0[2], r1[0], r1[2]}, sn = (f32x4){r0[1], r0[3], r1[1], r1[3]};
                        const f32x4 o1 = x1 * cs - x2 * sn, o2 = x1 * sn + x2 * cs;
                        bf16_t* zp = Z + (size_t)row * 2848 + c32 + 4 * fq;
                        u32x2 w; w.x = cvt_pk_bf16(o1[0], o1[1]); w.y = cvt_pk_bf16(o1[2], o1[3]); *(u32x2*)zp = w;
                        w.x = cvt_pk_bf16(o2[0], o2[1]); w.y = cvt_pk_bf16(o2[2], o2[3]); *(u32x2*)(zp + 16) = w; }
            } else {
                const float sc = ((c32 >= 512 && c32 < 768) || (c32 >= 2048 && c32 < 2560)) ? 0.125f : 1.0f;
                const bool kv32 = (!lat) && c32 >= 2560 && c32 < 2816;
                float* ob = c32 < 2688 ? outk : outv; const int cc = (c32 < 2688 ? c32 - 2560 : c32 - 2688) + 4 * fq;
#pragma unroll
                for (int ai = 0; ai < 2; ++ai)
#pragma unroll
                    for (int m = 0; m < 4; ++m) { const int row = rowb + ai * HALF + m * 16; bf16_t* zp = Z + (size_t)row * 2848 + c32 + 4 * fq;
#pragma unroll
                        for (int n = 0; n < 2; ++n) { const f32x4 v = acc[ai][bj][m][n] * sc; u32x2 w; w.x = cvt_pk_bf16(v[0], v[1]); w.y = cvt_pk_bf16(v[2], v[3]); *(u32x2*)(zp + 16 * n) = w;
                            if (kv32) *(f32x4*)(ob + (size_t)u.pm * 65536 + (size_t)(row & 255) * 128 + cc + 16 * n) = v; } }
            }
        }
    }
};
template <int MODE> struct EpiGlu {
    static constexpr bool PERM = true, AFTER_DRAIN = false;
    bf16_t* O; int ldc;
    __device__ __forceinline__ void operator()(const f32x4 (&acc)[2][2][4][2], const Unit& u, int wr, int wc, int fr, int fq) const {
        int row0 = u.pm * BM + wr * 64 + fr; asm volatile("" : "+v"(row0)); const int col0 = u.pn * HALF + wc * 32 + 8 * fq;
#pragma unroll
        for (int ai = 0; ai < 2; ++ai)
#pragma unroll
            for (int m = 0; m < 4; ++m) { bf16_t* rowp = O + (size_t)(row0 + ai * HALF + m * 16) * ldc + col0;
                f32x4 v[2];
#pragma unroll
                for (int n = 0; n < 2; ++n) { const f32x4 a = acc[ai][0][m][n], b = acc[ai][1][m][n];
#pragma unroll
                    for (int j = 0; j < 4; ++j) v[n][j] = MODE == 0 ? a[j] * sigmoidf_(b[j]) : a[j] * sigmoidf_(a[j]) * b[j]; }
                u32x4 w; w.x = cvt_pk_bf16(v[0][0], v[0][1]); w.y = cvt_pk_bf16(v[0][2], v[0][3]); w.z = cvt_pk_bf16(v[1][0], v[1][1]); w.w = cvt_pk_bf16(v[1][2], v[1][3]);
                *(u32x4*)rowp = w; }
    }
};
struct EpiBranch {
    static constexpr bool PERM = false, AFTER_DRAIN = false;
    const bf16_t* G; float* MF; bf16_t* MB;
    __device__ __forceinline__ void operator()(const f32x4 (&acc)[2][2][4][2], const Unit& u, int wr, int wc, int fr, int fq) const {
        int row0 = u.pm * BM + wr * 64 + fr; asm volatile("" : "+v"(row0)); const int col0 = u.pn * BM + wc * 32 + 4 * fq, sel = u.sel;
#pragma unroll
        for (int ai = 0; ai < 2; ++ai)
#pragma unroll
            for (int m = 0; m < 4; ++m) { const size_t row = (size_t)(row0 + ai * HALF + m * 16);
#pragma unroll
                for (int bj = 0; bj < 2; ++bj)
#pragma unroll
                    for (int n = 0; n < 2; ++n) { const int col = col0 + bj * HALF + n * 16;
                        const u32x2 gw = *(const u32x2*)(G + row * 3072 + sel * 1024 + col);
                        f32x4 v = acc[ai][bj][m][n] * (f32x4){bf_lo(gw.x), bf_hi(gw.x), bf_lo(gw.y), bf_hi(gw.y)};
                        if (sel > 0) v += *(const f32x4*)(MF + row * 1024 + col);
                        if (sel < 2) *(f32x4*)(MF + row * 1024 + col) = v;
                        else { u32x2 w; w.x = cvt_pk_bf16(v[0], v[1]); w.y = cvt_pk_bf16(v[2], v[3]); *(u32x2*)(MB + row * 1024 + col) = w; } } }
    }
};
struct EpiF32 {
    static constexpr bool PERM = false, AFTER_DRAIN = false;
    float* C; int ldc;
    __device__ __forceinline__ void operator()(const f32x4 (&acc)[2][2][4][2], const Unit& u, int wr, int wc, int fr, int fq) const {
        int row0 = u.pm * BM + wr * 64 + fr; asm volatile("" : "+v"(row0)); const int col0 = u.pn * BM + wc * 32 + 4 * fq;
#pragma unroll
        for (int ai = 0; ai < 2; ++ai)
#pragma unroll
            for (int m = 0; m < 4; ++m) { float* rowp = C + (size_t)(row0 + ai * HALF + m * 16) * ldc + col0;
#pragma unroll
                for (int bj = 0; bj < 2; ++bj)
#pragma unroll
                    for (int n = 0; n < 2; ++n) *(f32x4*)(rowp + bj * HALF + n * 16) = acc[ai][bj][m][n]; }
    }
};

template <class Epi, class Sched, bool ALIGN_EPI>
__device__ __forceinline__ void gemm_phase(PG8_LAS unsigned char* lds, const Gemm g, const Sched& S, const Epi& E, const int tid) {
    const int wid = __builtin_amdgcn_readfirstlane(tid >> 6), lane = tid & 63, wr = wid >> 2, wc = wid & 3, fr = lane & 15, fq = lane >> 4;
    const int K = g.K, nt = K / BK;
    unsigned voffA[2], voffB[2];
#pragma unroll
    for (int i = 0; i < 2; ++i) { int R, C; stage_rc(tid * 16 + i * 8192, R, C); const int Rb = Epi::PERM ? ((R & ~31) + perm32(R & 31)) : R;
        voffA[i] = (unsigned)(R * K + C) * 2u; voffB[i] = (unsigned)(Rb * K + C) * 2u; }
    const size_t kstep = (size_t)(BK * 2);
    const size_t hstep = (size_t)HALF * K * 2;
    const size_t tstep = 2 * hstep;
    const unsigned ldsw = (unsigned)wid * 1024u;
    const int aoff = lds_byte(wr * 64 + fr, fq * 8), boff = lds_byte(wc * 32 + fr, fq * 8);
#define PG8_SA(b, h) (((b) * 2 + (h)) * HTB)
#define PG8_SB(b, h) ((4 + (b) * 2 + (h)) * HTB)
#define PG8_STAGE(bufoff, gbase, voff) do { _Pragma("unroll") for (int _i = 0; _i < 2; ++_i) \
        __builtin_amdgcn_global_load_lds((const unsigned*)((const char*)(gbase) + (voff)[_i]), (PG8_LAS unsigned*)(lds + (bufoff) + ldsw + _i * 8192), 16, 0, 0); } while (0)
#define PG8_LDA(dst, b, h) do { _Pragma("unroll") for (int m = 0; m < 4; ++m) _Pragma("unroll") for (int k = 0; k < 2; ++k) dst[m][k] = *(const PG8_LAS bf16x8*)(lds + PG8_SA(b, h) + aoff + m * 2048 + k * 1024); } while (0)
#define PG8_LDB(dst, b, h) do { _Pragma("unroll") for (int n = 0; n < 2; ++n) _Pragma("unroll") for (int k = 0; k < 2; ++k) dst[n][k] = *(const PG8_LAS bf16x8*)(lds + PG8_SB(b, h) + boff + n * 2048 + k * 1024); } while (0)
#define PG8_MMA(ai, bj, At, Bt) do { __builtin_amdgcn_s_setprio(1); _Pragma("unroll") for (int m = 0; m < 4; ++m) _Pragma("unroll") for (int n = 0; n < 2; ++n) _Pragma("unroll") for (int k = 0; k < 2; ++k) \
        acc[ai][bj][m][n] = __builtin_amdgcn_mfma_f32_16x16x32_bf16(Bt[n][k], At[m][k], acc[ai][bj][m][n], 0, 0, 0); __builtin_amdgcn_s_setprio(0); } while (0)
#define PG8_WAIT_V(n) asm volatile("s_waitcnt vmcnt(" #n ")" ::: "memory")
#define PG8_WAIT_L(n) asm volatile("s_waitcnt lgkmcnt(" #n ")" ::: "memory")
#define PG8_BAR __builtin_amdgcn_s_barrier()
#define PG8_SCHED __builtin_amdgcn_sched_barrier(0)
    Unit cur, nxt; int ui = 0;
    if (!S.next(0, cur)) return;
    f32x4 acc[2][2][4][2];
#pragma unroll
    for (int a = 0; a < 2; ++a)
#pragma unroll
        for (int b = 0; b < 2; ++b)
#pragma unroll
            for (int m = 0; m < 4; ++m)
#pragma unroll
                for (int n = 0; n < 2; ++n) acc[a][b][m][n] = (f32x4){0.f, 0.f, 0.f, 0.f};
    bf16x8 At[4][2], B0[2][2], B1[2][2];
    const char* cA = S.a_base(g, cur, tstep); const char* cB = S.b_base(g, cur, tstep);
    PG8_STAGE(PG8_SB(0, 0), cB, voffB); PG8_STAGE(PG8_SB(0, 1), cB + hstep, voffB); PG8_STAGE(PG8_SA(0, 0), cA, voffA); PG8_STAGE(PG8_SA(0, 1), cA + hstep, voffA);
    if (wr == 1) PG8_BAR;
    PG8_WAIT_V(2); PG8_BAR;
    PG8_STAGE(PG8_SB(1, 0), cB + kstep, voffB); PG8_STAGE(PG8_SA(1, 0), cA + kstep, voffA); PG8_STAGE(PG8_SB(1, 1), cB + hstep + kstep, voffB);
    PG8_WAIT_V(6); PG8_BAR;
    for (;;) {
        const bool has_next = S.next(ui + 1, nxt);
        const char* nA = has_next ? S.a_base(g, nxt, tstep) : cA; const char* nB = has_next ? S.b_base(g, nxt, tstep) : cB;
        for (int t = 0; t < nt; t += 2) {
            const bool last = (t == nt - 2);
            const char* a1 = cA + (size_t)(t + 1) * kstep;
            const char* a2 = last ? nA : cA + (size_t)(t + 2) * kstep; const char* b2 = last ? nB : cB + (size_t)(t + 2) * kstep;
            const char* a3 = a2 + kstep; const char* b3 = b2 + kstep;
            PG8_LDB(B0, 0, 0); PG8_LDB(B1, 0, 1); PG8_SCHED; PG8_LDA(At, 0, 0); PG8_STAGE(PG8_SA(1, 1), a1 + hstep, voffA);
            PG8_WAIT_V(8); PG8_WAIT_L(0); PG8_BAR; PG8_MMA(0, 0, At, B0); PG8_MMA(0, 1, At, B1); PG8_BAR; PG8_SCHED;
            PG8_LDA(At, 0, 1); PG8_STAGE(PG8_SB(0, 0), b2, voffB); PG8_STAGE(PG8_SB(0, 1), b2 + hstep, voffB); PG8_STAGE(PG8_SA(0, 0), a2, voffA);
            PG8_WAIT_V(8); PG8_WAIT_L(0); PG8_BAR; PG8_MMA(1, 0, At, B0); PG8_MMA(1, 1, At, B1); PG8_BAR; PG8_SCHED;
            PG8_LDB(B0, 1, 0); PG8_LDB(B1, 1, 1); PG8_SCHED; PG8_LDA(At, 1, 0); PG8_STAGE(PG8_SA(0, 1), a2 + hstep, voffA);
            PG8_WAIT_V(8); PG8_WAIT_L(0); PG8_BAR; PG8_MMA(0, 0, At, B0); PG8_MMA(0, 1, At, B1); PG8_BAR; PG8_SCHED;
            PG8_LDA(At, 1, 1); PG8_STAGE(PG8_SB(1, 0), b3, voffB); PG8_STAGE(PG8_SB(1, 1), b3 + hstep, voffB); PG8_STAGE(PG8_SA(1, 0), a3, voffA);
            PG8_WAIT_V(8); PG8_WAIT_L(0); PG8_BAR; PG8_MMA(1, 0, At, B0); PG8_MMA(1, 1, At, B1); PG8_BAR; PG8_SCHED;
        }
        if constexpr (ALIGN_EPI) { if (wr == 0) PG8_BAR; }
        E(acc, cur, wr, wc, fr, fq);
        if (!has_next) break;
#pragma unroll
        for (int a = 0; a < 2; ++a)
#pragma unroll
            for (int b = 0; b < 2; ++b)
#pragma unroll
                for (int m = 0; m < 4; ++m)
#pragma unroll
                    for (int n = 0; n < 2; ++n) acc[a][b][m][n] = (f32x4){0.f, 0.f, 0.f, 0.f};
        cur = nxt; cA = nA; cB = nB; ++ui;
        if constexpr (ALIGN_EPI) { if (wr == 1) PG8_BAR; }
    }
    PG8_WAIT_V(0);
    if constexpr (!ALIGN_EPI) { if (wr == 0) PG8_BAR; }
    PG8_BAR;
#undef PG8_SA
#undef PG8_SB
#undef PG8_STAGE
#undef PG8_LDA
#undef PG8_LDB
#undef PG8_MMA
#undef PG8_WAIT_V
#undef PG8_WAIT_L
#undef PG8_BAR
#undef PG8_SCHED
}
}

constexpr int NWAVES = 8;
constexpr int DM = 1024, M_CTX = 4096, M_TOK = 12288, L_CTX = 256, L_LAT = 1024;
constexpr int ZP = 2848, GP = 3072, NZ = 6144, D_IN = 5920, FFH = 2816, FF2 = 5632;
constexpr float RMS_EPS = 1e-6f;
constexpr size_t O_Y = 0, O_CK = 12582912, O_CV = 13631488, O_S5 = 14680064, O_GLA = 14942208, O_END = 17039360;
enum { I_XP = 0, I_XS, I_CK, I_CV, I_SS5, I_SGLA, I_C, I_CCTX, I_WMOD, I_BMOD, I_NORMG, I_WIN, I_LRE, I_LIM, I_LSTEP, I_BRE, I_BIM, I_CRE, I_CIM, I_S5D, I_WGLU, I_WGK, I_BGK, I_GNG, I_SINK, I_WBR, I_WOUT, I_W1, I_W2, N_IN };

constexpr size_t MiB = 1u << 20;
constexpr size_t WS_CTL = 0, CTL_ZERO_BYTES = 64 * 1024;
constexpr size_t WS_MOD = 64 * 1024;
constexpr size_t WS_ROPE = 512 * 1024;
constexpr size_t WS_CKV = 1 * MiB;
constexpr size_t WS_W = 3 * MiB;
constexpr size_t WS_XN = 38 * MiB;
constexpr size_t WS_Z = 62 * MiB;
constexpr size_t WS_G = 129 * MiB;
constexpr size_t WS_GS = 201 * MiB;
constexpr size_t WS_Y = 225 * MiB;
constexpr size_t WS_END = 249 * MiB;
constexpr size_t WO_IN = 0, WO_GLU = 6291456, WO_BR = 6815744, WO_OUT = 8388608, WO_W1 = 9437184, WO_W2 = 15204352, WO_END = 18087936;
static_assert(WS_W + WO_END * 2 <= WS_XN && WS_XN + (size_t)M_TOK * 1024 * 2 <= WS_Z && WS_Z + (size_t)M_TOK * ZP * 2 <= WS_G && WS_G + (size_t)M_TOK * GP * 2 <= WS_GS && WS_GS + (size_t)M_TOK * 1024 * 2 <= WS_Y && WS_Y + (size_t)M_TOK * 1024 * 2 <= WS_END, "d_ws map");
constexpr int CW_BAR = 1024;

constexpr int RING_OFF = 0, RING_BYTES = 131072;
constexpr int LDSCTL_OFF = RING_BYTES, MISC_OFF = LDSCTL_OFF + 320;
constexpr int LDS_BYTES = 147456;
static_assert(MISC_OFF + 128 <= LDS_BYTES, "LDS map");

#define GAS __attribute__((address_space(1)))
#define LAS __attribute__((address_space(3)))
typedef unsigned short bf16;
typedef unsigned v4u __attribute__((ext_vector_type(4)));
typedef unsigned v2u __attribute__((ext_vector_type(2)));
typedef float f32x4 __attribute__((ext_vector_type(4)));
#define LDS_WAIT() asm volatile("s_waitcnt lgkmcnt(0)" ::: "memory")
__device__ __forceinline__ unsigned f2bf(float f) { unsigned u = __builtin_bit_cast(unsigned, f); return (u + 0x7fffu + ((u >> 16) & 1u)) >> 16; }
__device__ __forceinline__ unsigned pk2(float lo, float hi) { return f2bf(lo) | (f2bf(hi) << 16); }
__device__ __forceinline__ float bf2f(bf16 b) { return __builtin_bit_cast(float, ((unsigned)b) << 16); }
__device__ __forceinline__ float bflo(unsigned w) { return __builtin_bit_cast(float, w << 16); }
__device__ __forceinline__ float bfhi(unsigned w) { return __builtin_bit_cast(float, w & 0xffff0000u); }

#define XB_TMO      128
#define XB_XCNT(j)  (256  + 64 * (j))
#define XB_XSUB(j)  (1280 + 64 * (j))
#define XB_XGEN(j)  (2304 + 64 * (j))
#define XB_TOP      3328
#define XB_TOPGEN   3392
#define XCD_BAR_WORDS 3456
#define XB_SPIN_CAP (1u << 22)

__device__ __forceinline__ unsigned xb_ld(unsigned* p)              { return __hip_atomic_load(p, __ATOMIC_RELAXED, __HIP_MEMORY_SCOPE_AGENT); }
__device__ __forceinline__ unsigned xb_add(unsigned* p, unsigned v) { return __hip_atomic_fetch_add(p, v, __ATOMIC_RELAXED, __HIP_MEMORY_SCOPE_AGENT); }
__device__ __forceinline__ unsigned xb_xcc_id() { return (unsigned)__builtin_amdgcn_s_getreg((3 << 11) | 20) & 0xFu; }
#define XB_SPIN(cond, bar) do { unsigned _sp = 0; while (cond) { __builtin_amdgcn_s_sleep(1); \
    if ((++_sp & 255u) == 0u) { if (xb_ld(&(bar)[XB_TMO])) break; if (_sp > XB_SPIN_CAP) { atomicAdd(&(bar)[XB_TMO], 1u); break; } } } } while (0)

struct XcdBarrier {
    unsigned* bar; unsigned x;
    volatile LAS unsigned* st;
};

__device__ __forceinline__ XcdBarrier xcd_barrier_post(unsigned* bar, volatile LAS unsigned* st) {
    XcdBarrier b; b.bar = bar; b.x = xb_xcc_id(); b.st = st;
    if (threadIdx.x == 0) (void)xb_add(&bar[XB_XCNT(b.x)], 1u);
    return b;
}
__device__ __forceinline__ void xcd_barrier_complete(unsigned* bar, unsigned x, unsigned& nloc, unsigned& nx) {
    const unsigned G = gridDim.x * gridDim.y * gridDim.z;
    unsigned sum, cnt, mine, sp = 0u;
    for (;;) {
        sum = 0u; cnt = 0u; mine = 0u;
#pragma unroll
        for (unsigned j = 0; j < 16; ++j) { const unsigned c = xb_ld(&bar[XB_XCNT(j)]); sum += c; cnt += (c > 0u) ? 1u : 0u; mine = (j == x) ? c : mine; }
        if (sum == G) break;
        __builtin_amdgcn_s_sleep(1);
        if ((++sp & 255u) == 0u) { if (xb_ld(&bar[XB_TMO])) break; if (sp > XB_SPIN_CAP) { atomicAdd(&bar[XB_TMO], 1u); break; } }
    }
    nloc = mine > 0u ? mine : 1u; nx = cnt > 0u ? cnt : 1u;
}

__device__ __forceinline__ void xcd_barrier(const XcdBarrier& b) {
    asm volatile("s_waitcnt vmcnt(0)" ::: "memory");
    __syncthreads();
    if (threadIdx.x == 0) {
        unsigned* bar = b.bar;
        __builtin_amdgcn_s_waitcnt(0);
        unsigned nloc = b.st[0], nx = b.st[1];
        if (nloc == 0u) { xcd_barrier_complete(bar, b.x, nloc, nx); b.st[0] = nloc; b.st[1] = nx; }
        const unsigned old = xb_add(&bar[XB_XSUB(b.x)], 1u);
        const unsigned gen = old / nloc;
        if (old + 1u == (gen + 1u) * nloc) {
            __builtin_amdgcn_fence(__ATOMIC_RELEASE, "agent");
            asm volatile("s_waitcnt vmcnt(0)" ::: "memory");
            const unsigned og = xb_add(&bar[XB_TOP], 1u);
            const unsigned tg = og / nx;
            if (og + 1u == (tg + 1u) * nx) xb_add(&bar[XB_TOPGEN], 1u);
            else XB_SPIN(xb_ld(&bar[XB_TOPGEN]) == tg, bar);
            __builtin_amdgcn_fence(__ATOMIC_ACQUIRE, "agent");
            xb_add(&bar[XB_XGEN(b.x)], 1u);
            asm volatile("s_waitcnt vmcnt(0)" ::: "memory");
        } else {
            XB_SPIN(xb_ld(&bar[XB_XGEN(b.x)]) == gen, bar);
            __builtin_amdgcn_fence(__ATOMIC_ACQUIRE, "agent");
            asm volatile("s_waitcnt vmcnt(0)" ::: "memory");
        }
    }
    __syncthreads();
}


struct Args { const float* in[N_IN]; float* out; unsigned char* ws; int ph_lo, ph_hi; };
static_assert(sizeof(Args) == (N_IN + 2) * 8 + 8, "Args has no padding");
typedef const float* cfptr_t;
typedef const __attribute__((address_space(4))) cfptr_t* kargs_t;
struct Frame {
    unsigned char* lds;
    int tid, lane, wave, G, bid;
    kargs_t in; float* out; unsigned char* ws;
};
__device__ __forceinline__ float wave_sum(float v) {
#pragma unroll
    for (int o = 1; o < 64; o <<= 1) v += __shfl_xor(v, o);
    return v;
}
__device__ __forceinline__ const float* xin_row(const Frame& F, int row) { return row < M_CTX ? F.in[I_XP] + (size_t)row * DM : F.in[I_XS] + (size_t)(row - M_CTX) * DM; }
__device__ __forceinline__ int path_of(int row) { return row < M_CTX ? 0 : 1 + ((row - M_CTX) >> 10); }

__device__ __forceinline__ int map_row(int mapk, int n0) {
    if (mapk == 0) return n0;
    if (mapk == 1) { if (n0 < 2048) return n0; if (n0 < 2080) return 2816 + (n0 - 2048); if (n0 < 2848) return 2048 + (n0 - 2080); return 3072 + (n0 - 2848); }
    const int half = mapk == 2 ? 512 : 2816;
    if (n0 < half) return (n0 / 128) * 256 + (n0 % 128);
    const int s = n0 - half; return (s / 128) * 256 + 128 + (s % 128);
}
__device__ __forceinline__ void p0_transpose_item(const float* W, int K, int N, bf16* WT, int mapk, float* scr, int item, int lane) {
    const int nblk = N / 32, kb = item / nblk, nb = item % nblk, k0 = 64 * kb, n0 = 32 * nb, d0 = map_row(mapk, n0);
    float tv[32];
#pragma unroll
    for (int i = 0; i < 32; ++i) { const int kk = 2 * i + (lane >> 5); tv[i] = W[(size_t)(k0 + kk) * N + n0 + (lane & 31)]; }
#pragma unroll
    for (int i = 0; i < 32; ++i) { const int kk = 2 * i + (lane >> 5); scr[kk * 33 + (lane & 31)] = tv[i]; }
    LDS_WAIT(); asm volatile("" ::: "memory");
    const int c = lane & 7;
#pragma unroll
    for (int j = 0; j < 4; ++j) { const int n = (lane >> 3) + 8 * j; const float* s = scr + (8 * c) * 33 + n;
        v4u o; o.x = pk2(s[0 * 33], s[1 * 33]); o.y = pk2(s[2 * 33], s[3 * 33]); o.z = pk2(s[4 * 33], s[5 * 33]); o.w = pk2(s[6 * 33], s[7 * 33]);
        *(v4u*)(WT + (size_t)(d0 + n) * K + k0 + 8 * c) = o; }
    LDS_WAIT(); asm volatile("" ::: "memory");
}
__device__ __forceinline__ void convert_weights(const Frame& F, int l) {
    float* scr = (float*)(F.lds + RING_OFF + F.wave * 16384);
    bf16* WT = (bf16*)(F.ws + WS_W);
    const int gw = F.bid * NWAVES + F.wave, NGW = F.G * NWAVES;
    constexpr int I0 = 16 * 185, I1 = 8 * 32, I2 = 3 * 8 * 32, I3 = 16 * 32, I4 = 16 * 176, I5 = 44 * 32;
    for (int it = gw; it < I0 + I1 + I2 + I3 + I4 + I5; it += NGW) {
        int r = it;
        if (r < I0) { p0_transpose_item(F.in[I_WIN] + (size_t)l * 1024 * D_IN, 1024, D_IN, WT + WO_IN, 1, scr, r, F.lane); continue; } r -= I0;
        if (r < I1) { p0_transpose_item(F.in[I_WGLU] + (size_t)l * 512 * 1024, 512, 1024, WT + WO_GLU, 2, scr, r, F.lane); continue; } r -= I1;
        if (r < I2) { const int n = r / 256; p0_transpose_item(F.in[I_WBR] + (size_t)(l * 3 + n) * 512 * 1024, 512, 1024, WT + WO_BR + (size_t)n * 1024 * 512, 0, scr, r % 256, F.lane); continue; } r -= I2;
        if (r < I3) { p0_transpose_item(F.in[I_WOUT] + (size_t)l * 1024 * 1024, 1024, 1024, WT + WO_OUT, 0, scr, r, F.lane); continue; } r -= I3;
        if (r < I4) { p0_transpose_item(F.in[I_W1] + (size_t)l * 1024 * FF2, 1024, FF2, WT + WO_W1, 3, scr, r, F.lane); continue; } r -= I4;
        p0_transpose_item(F.in[I_W2] + (size_t)l * FFH * 1024, FFH, 1024, WT + WO_W2, 0, scr, r, F.lane);
    }
}
__device__ __forceinline__ void mod_items(const Frame& F) {
    float* SC = (float*)(F.lds);
    float* RED = (float*)(F.lds + 40960);
    float* MOD = (float*)(F.ws + WS_MOD);
    if (F.bid >= 192) return;
    for (int i = F.tid; i < 9 * 1024; i += NWAVES * 64) { const float c = i < 1024 ? F.in[I_CCTX][i] : F.in[I_C][i - 1024]; SC[i] = c / (1.0f + __expf(-c)); }
    __syncthreads();
    const int item = F.bid, l = item / 96, col = (item % 96) * 64 + F.lane;
    const float* wm = F.in[I_WMOD] + ((size_t)l * 1024 + F.wave * 128) * 6144 + col;
    float acc[9];
#pragma unroll
    for (int r = 0; r < 9; ++r) acc[r] = 0.f;
    for (int k0 = 0; k0 < 128; k0 += 32) { float wv[32];
#pragma unroll
        for (int kk = 0; kk < 32; ++kk) wv[kk] = wm[(size_t)(k0 + kk) * 6144];
#pragma unroll
        for (int kk = 0; kk < 32; ++kk) { const int k = F.wave * 128 + k0 + kk;
#pragma unroll
            for (int r = 0; r < 9; ++r) acc[r] += SC[r * 1024 + k] * wv[kk]; } }
#pragma unroll
    for (int r = 0; r < 9; ++r) RED[(F.wave * 9 + r) * 64 + F.lane] = acc[r];
    __syncthreads();
    for (int o = F.tid; o < 576; o += NWAVES * 64) { const int r = o >> 6, ln = o & 63; float s = F.in[I_BMOD][l * 6144 + (item % 96) * 64 + ln];
#pragma unroll
        for (int w = 0; w < 8; ++w) s += RED[(w * 9 + r) * 64 + ln];
        MOD[(size_t)(l * 9 + r) * 6144 + (item % 96) * 64 + ln] = s; }
    __syncthreads();
}
__device__ __forceinline__ void p0_prologue(const Frame& F) {
    mod_items(F);
    const int gt = F.bid * (NWAVES * 64) + F.tid, NGT = F.G * NWAVES * 64;
    if (gt < 1024) { const int pos = gt >> 4, q = gt & 15; const float inv = powf(10000.0f, -(float)q / 16.0f), ang = (float)pos * inv; float* rp = (float*)(F.ws + WS_ROPE); rp[gt * 2] = cosf(ang); rp[gt * 2 + 1] = sinf(ang); }
    { bf16* ck = (bf16*)(F.ws + WS_CKV); bf16* cv = ck + 524288;
      for (int i = gt; i < 524288; i += NGT) { const int c = i & 127, j = (i >> 7) & 255, b = (i >> 15) & 7, l = i >> 18; const size_t s = ((size_t)((b * 2 + l) * 256 + j)) * 128 + c;
          ck[i] = (bf16)f2bf(F.in[I_CK][s]); cv[i] = (bf16)f2bf(F.in[I_CV][s]); } }
    convert_weights(F, 0);
}

__device__ __forceinline__ void norm_phase(const Frame& F, int l, int mode) {
    const int gw = F.bid * NWAVES + F.wave, NGW = F.G * NWAVES;
    const float* MOD = (const float*)(F.ws + WS_MOD);
    const float* RAW = (const float*)(F.ws + WS_Z);
    bf16* XN = (bf16*)(F.ws + WS_XN);
    float* X = F.out + O_Y;
    for (int rp = gw; rp < M_TOK / 2; rp += NGW) {
        const int row = 2 * rp, pb = path_of(row);
        const float* modl = MOD + (size_t)(l * 9 + pb) * 6144;
        const float* ng = F.in[I_NORMG] + l * 4096;
        f32x4 xv[2][4];
#pragma unroll
        for (int q = 0; q < 2; ++q) { const float* xs = (mode == 2 || l == 1) ? X + (size_t)(row + q) * DM : xin_row(F, row + q);
#pragma unroll
            for (int j = 0; j < 4; ++j) xv[q][j] = ((const f32x4*)xs)[F.lane + 64 * j]; }
        if (mode >= 1) {
            f32x4 rv[2][4]; float ss[2] = {0.f, 0.f};
#pragma unroll
            for (int q = 0; q < 2; ++q)
#pragma unroll
                for (int j = 0; j < 4; ++j) { rv[q][j] = ((const f32x4*)(RAW + (size_t)(row + q) * DM))[F.lane + 64 * j]; ss[q] += rv[q][j].x * rv[q][j].x + rv[q][j].y * rv[q][j].y + rv[q][j].z * rv[q][j].z + rv[q][j].w * rv[q][j].w; }
            const float* gate = modl + (mode == 1 ? 2048 : 5120); const float* nga = ng + (mode == 1 ? 1024 : 3072);
            f32x4 gn[4];
#pragma unroll
            for (int j = 0; j < 4; ++j) gn[j] = ((const f32x4*)gate)[F.lane + 64 * j] * ((const f32x4*)nga)[F.lane + 64 * j];
            const float r0 = 1.0f / sqrtf(wave_sum(ss[0]) * (1.0f / DM) + RMS_EPS), r1 = 1.0f / sqrtf(wave_sum(ss[1]) * (1.0f / DM) + RMS_EPS);
#pragma unroll
            for (int j = 0; j < 4; ++j) { xv[0][j] = xv[0][j] + gn[j] * (rv[0][j] * r0); xv[1][j] = xv[1][j] + gn[j] * (rv[1][j] * r1);
                ((f32x4*)(X + (size_t)row * DM))[F.lane + 64 * j] = xv[0][j]; ((f32x4*)(X + (size_t)(row + 1) * DM))[F.lane + 64 * j] = xv[1][j]; }
        }
        if (mode == 2 && l == 1) continue;
        const int ln = mode == 2 ? l + 1 : l;
        const float* modn = MOD + (size_t)(ln * 9 + pb) * 6144;
        const float* ngb = F.in[I_NORMG] + ln * 4096 + (mode == 1 ? 2048 : 0);
        const float* sc = modn + (mode == 1 ? 4096 : 1024); const float* sh = modn + (mode == 1 ? 3072 : 0);
        float s0 = 0.f, s1 = 0.f;
#pragma unroll
        for (int j = 0; j < 4; ++j) { s0 += xv[0][j].x * xv[0][j].x + xv[0][j].y * xv[0][j].y + xv[0][j].z * xv[0][j].z + xv[0][j].w * xv[0][j].w; s1 += xv[1][j].x * xv[1][j].x + xv[1][j].y * xv[1][j].y + xv[1][j].z * xv[1][j].z + xv[1][j].w * xv[1][j].w; }
        const float q0 = 1.0f / sqrtf(wave_sum(s0) * (1.0f / DM) + RMS_EPS), q1 = 1.0f / sqrtf(wave_sum(s1) * (1.0f / DM) + RMS_EPS);
#pragma unroll
        for (int j = 0; j < 4; ++j) { const f32x4 nv = ((const f32x4*)ngb)[F.lane + 64 * j] * (((const f32x4*)sc)[F.lane + 64 * j] + 1.0f), hv = ((const f32x4*)sh)[F.lane + 64 * j];
            const f32x4 o0 = xv[0][j] * q0 * nv + hv, o1 = xv[1][j] * q1 * nv + hv; v2u w0, w1; w0.x = pk2(o0.x, o0.y); w0.y = pk2(o0.z, o0.w); w1.x = pk2(o1.x, o1.y); w1.y = pk2(o1.z, o1.w);
            ((v2u*)(XN + (size_t)row * DM))[F.lane + 64 * j] = w0; ((v2u*)(XN + (size_t)(row + 1) * DM))[F.lane + 64 * j] = w1; }
    }
}

__device__ __forceinline__ float gelu_tanh(float x) { const float u = 0.7978845608028654f * (x + 0.044715f * x * x * x); return 0.5f * x * (1.0f + tanhf(u)); }
typedef float f32x16 __attribute__((ext_vector_type(16)));
typedef short bf16x8 __attribute__((ext_vector_type(8)));
typedef short bf16x4 __attribute__((ext_vector_type(4)));
#define MFMA32(a, b, c) __builtin_amdgcn_mfma_f32_32x32x16_bf16((a), (b), (c), 0, 0, 0)
typedef __bf16 bf16pair_t __attribute__((ext_vector_type(2)));
#define DOT2(a, b, c) __builtin_amdgcn_fdot2_f32_bf16(__builtin_bit_cast(bf16pair_t, (unsigned)(a)), __builtin_bit_cast(bf16pair_t, (unsigned)(b)), (c), false)
__device__ __forceinline__ unsigned cvtpk(float lo, float hi) { unsigned r; asm("v_cvt_pk_bf16_f32 %0, %1, %2" : "=v"(r) : "v"(lo), "v"(hi)); return r; }
__device__ __forceinline__ void lds_barrier() { asm volatile("s_waitcnt lgkmcnt(0)\n\ts_barrier" ::: "memory"); }
__device__ __forceinline__ int crow(int r, int hh) { return (r & 3) + 8 * (r >> 2) + 4 * hh; }
__device__ __forceinline__ bf16x8 acc_frag(const f32x16& a, int s) {
    v4u w; w.x = cvtpk(a[8 * s + 0], a[8 * s + 1]); w.y = cvtpk(a[8 * s + 2], a[8 * s + 3]); w.z = cvtpk(a[8 * s + 4], a[8 * s + 5]); w.w = cvtpk(a[8 * s + 6], a[8 * s + 7]);
    return __builtin_bit_cast(bf16x8, w);
}
__device__ __forceinline__ bf16x8 cat4(bf16x4 a, bf16x4 b) { return __builtin_shufflevector(a, b, 0, 1, 2, 3, 4, 5, 6, 7); }

typedef float f32x4m __attribute__((ext_vector_type(4)));
constexpr int S5_HS = 272, S5_WB = 32 * S5_HS;
__device__ __forceinline__ float gelu_fast(float x) { const float u = 0.7978845608028654f * (x + 0.044715f * x * x * x); const float e = __expf(2.0f * u); return 0.5f * x * (2.0f - 2.0f / (1.0f + e)); }
__device__ __forceinline__ void s5_item(const Frame& F, int l, int item) {
    const int w = F.wave, lane = F.lane, hh = lane >> 5, c31 = lane & 31, l15 = lane & 15, l4 = lane >> 4, pair = item * 4 + (w >> 1), d = w & 1;
    const bool lat = pair < 256; const int pp = lat ? pair : pair - 256, b = pp >> 5, g = pp & 31;
    const int L = lat ? L_LAT : L_CTX, row0 = lat ? M_CTX + b * L_LAT : b * L_CTX, nch = L >> 5;
    const bf16* Z = (const bf16*)(F.ws + WS_Z); bf16* SS = (bf16*)(F.ws + WS_XN);
    unsigned char* Hb = F.lds + w * S5_WB;
    float ar[2], ai[2]; bf16x8 bfr[4], cfr[4]; float hr[2], hi[2];
#pragma unroll
    for (int q = 0; q < 2; ++q) {
        const int pidx = ((l * 2 + d) * 32 + g) * 64 + 32 * q + c31;
        const float lre = F.in[I_LRE][pidx], lim = F.in[I_LIM][pidx], dt = expf(F.in[I_LSTEP][pidx]);
        const float mag = expf(lre * dt); float sn, cs; sincosf(lim * dt, &sn, &cs);
        ar[q] = mag * cs; ai[q] = mag * sn; const float nr = ar[q] - 1.0f, ni = ai[q], den = lre * lre + lim * lim;
        const float fr = (nr * lre + ni * lim) / den, fi = (ni * lre - nr * lim) / den;
        const f32x4* brp = (const f32x4*)(F.in[I_BRE] + (size_t)pidx * 16 + 8 * hh); const f32x4* bip = (const f32x4*)(F.in[I_BIM] + (size_t)pidx * 16 + 8 * hh);
        const f32x4 br0 = brp[0], br1 = brp[1], bi0 = bip[0], bi1 = bip[1];
        v4u wr_, wi_;
        wr_.x = cvtpk(fr * br0[0] - fi * bi0[0], fr * br0[1] - fi * bi0[1]); wr_.y = cvtpk(fr * br0[2] - fi * bi0[2], fr * br0[3] - fi * bi0[3]); wr_.z = cvtpk(fr * br1[0] - fi * bi1[0], fr * br1[1] - fi * bi1[1]); wr_.w = cvtpk(fr * br1[2] - fi * bi1[2], fr * br1[3] - fi * bi1[3]);
        wi_.x = cvtpk(fr * bi0[0] + fi * br0[0], fr * bi0[1] + fi * br0[1]); wi_.y = cvtpk(fr * bi0[2] + fi * br0[2], fr * bi0[3] + fi * br0[3]); wi_.z = cvtpk(fr * bi1[0] + fi * br1[0], fr * bi1[1] + fi * br1[1]); wi_.w = cvtpk(fr * bi1[2] + fi * br1[2], fr * bi1[3] + fi * br1[3]);
        bfr[q] = __builtin_bit_cast(bf16x8, wr_); bfr[2 + q] = __builtin_bit_cast(bf16x8, wi_);
        hr[q] = 0.f; hi[q] = 0.f;
        if (lat) { const size_t si = ((size_t)((((b * 2 + l) * 2 + d) * 32 + g) * 64 + 32 * q + c31)) * 2; hr[q] = F.in[I_SS5][si]; hi[q] = F.in[I_SS5][si + 1]; }
    }
#pragma unroll
    for (int kk = 0; kk < 4; ++kk) {
        const size_t cb = ((size_t)(((l * 2 + d) * 32 + g) * 16 + l15)) * 64 + kk * 16 + 4 * l4;
        const f32x4 cr = *(const f32x4*)(F.in[I_CRE] + cb), ci = *(const f32x4*)(F.in[I_CIM] + cb);
        v4u wc_; wc_.x = cvtpk(cr[0], -ci[0]); wc_.y = cvtpk(cr[1], -ci[1]); wc_.z = cvtpk(cr[2], -ci[2]); wc_.w = cvtpk(cr[3], -ci[3]);
        cfr[kk] = __builtin_bit_cast(bf16x8, wc_);
    }
    float a2r[2], a2i[2], a3r[2], a3i[2], a4r[2], a4i[2];
#pragma unroll
    for (int q = 0; q < 2; ++q) { a2r[q] = ar[q] * ar[q] - ai[q] * ai[q]; a2i[q] = 2.0f * ar[q] * ai[q]; a3r[q] = a2r[q] * ar[q] - a2i[q] * ai[q]; a3i[q] = a2r[q] * ai[q] + a2i[q] * ar[q]; a4r[q] = a2r[q] * a2r[q] - a2i[q] * a2i[q]; a4i[q] = 2.0f * a2r[q] * a2i[q]; }
    const float dsk = F.in[I_S5D][l * 512 + g * 16 + l15];
    asm volatile("" ::: "memory");
    const f32x16 zero16 = {0.f, 0.f, 0.f, 0.f, 0.f, 0.f, 0.f, 0.f, 0.f, 0.f, 0.f, 0.f, 0.f, 0.f, 0.f, 0.f};
    bf16x8 unext = *(const bf16x8*)(Z + (size_t)(row0 + (d ? L - 1 - c31 : c31)) * ZP + g * 16 + 8 * hh);
    unsigned pv[8], uv[8];
#pragma unroll
    for (int k = 0; k < 8; ++k) { pv[k] = 0u; uv[k] = 0u; }
    for (int c = 0; c < nch; ++c) {
        const bf16x8 uf = unext;
        if (c + 1 < nch) { const int tau = 32 * (c + 1) + c31; unext = *(const bf16x8*)(Z + (size_t)(row0 + (d ? L - 1 - tau : tau)) * ZP + g * 16 + 8 * hh); }
        asm volatile("" ::: "memory");
        f32x16 bur0 = MFMA32(uf, bfr[0], zero16), bur1 = MFMA32(uf, bfr[1], zero16), bui0 = MFMA32(uf, bfr[2], zero16), bui1 = MFMA32(uf, bfr[3], zero16);
#pragma unroll
        for (int G = 0; G < 4; ++G)
#pragma unroll
            for (int i = 1; i < 4; ++i) { const int r = 4 * G + i;
                { const float pr = bur0[r - 1], pi = bui0[r - 1]; bur0[r] += ar[0] * pr - ai[0] * pi; bui0[r] += ar[0] * pi + ai[0] * pr; }
                { const float pr = bur1[r - 1], pi = bui1[r - 1]; bur1[r] += ar[1] * pr - ai[1] * pi; bui1[r] += ar[1] * pi + ai[1] * pr; } }
        float cnr0[4] = {0.f, 0.f, 0.f, 0.f}, cni0[4] = {0.f, 0.f, 0.f, 0.f}, cnr1[4] = {0.f, 0.f, 0.f, 0.f}, cni1[4] = {0.f, 0.f, 0.f, 0.f};
        float cr0 = hr[0], ci0 = hi[0], cr1 = hr[1], ci1 = hi[1];
#pragma unroll
        for (int g8 = 0; g8 < 8; ++g8) { const int G = g8 >> 1, r3 = 4 * G + 3; const bool own = hh == (g8 & 1);
            cnr0[G] = own ? cr0 : cnr0[G]; cni0[G] = own ? ci0 : cni0[G]; cnr1[G] = own ? cr1 : cnr1[G]; cni1[G] = own ? ci1 : cni1[G];
            const float n0 = a4r[0] * cr0 - a4i[0] * ci0 + bur0[r3], m0 = a4r[0] * ci0 + a4i[0] * cr0 + bui0[r3];
            const float n1 = a4r[1] * cr1 - a4i[1] * ci1 + bur1[r3], m1 = a4r[1] * ci1 + a4i[1] * cr1 + bui1[r3];
            { auto t = __builtin_amdgcn_permlane32_swap(__float_as_uint(n0), __float_as_uint(n0), false, false); cr0 = __uint_as_float(t[g8 & 1]); }
            { auto t = __builtin_amdgcn_permlane32_swap(__float_as_uint(m0), __float_as_uint(m0), false, false); ci0 = __uint_as_float(t[g8 & 1]); }
            { auto t = __builtin_amdgcn_permlane32_swap(__float_as_uint(n1), __float_as_uint(n1), false, false); cr1 = __uint_as_float(t[g8 & 1]); }
            { auto t = __builtin_amdgcn_permlane32_swap(__float_as_uint(m1), __float_as_uint(m1), false, false); ci1 = __uint_as_float(t[g8 & 1]); } }
        hr[0] = cr0; hi[0] = ci0; hr[1] = cr1; hi[1] = ci1;
#pragma unroll
        for (int r = 0; r < 16; ++r) { const int G = r >> 2, i = r & 3; unsigned char* hrow = Hb + crow(r, hh) * S5_HS;
            const float p0r = i == 0 ? ar[0] : (i == 1 ? a2r[0] : (i == 2 ? a3r[0] : a4r[0])), p0i = i == 0 ? ai[0] : (i == 1 ? a2i[0] : (i == 2 ? a3i[0] : a4i[0]));
            const float p1r = i == 0 ? ar[1] : (i == 1 ? a2r[1] : (i == 2 ? a3r[1] : a4r[1])), p1i = i == 0 ? ai[1] : (i == 1 ? a2i[1] : (i == 2 ? a3i[1] : a4i[1]));
            const float h0r = bur0[r] + p0r * cnr0[G] - p0i * cni0[G], h0i = bui0[r] + p0r * cni0[G] + p0i * cnr0[G];
            const float h1r = bur1[r] + p1r * cnr1[G] - p1i * cni1[G], h1i = bui1[r] + p1r * cni1[G] + p1i * cnr1[G];
            *(unsigned*)(hrow + c31 * 4) = cvtpk(h0r, h0i); *(unsigned*)(hrow + (32 + c31) * 4) = cvtpk(h1r, h1i); }
        asm volatile("" ::: "memory");
        f32x4m y0 = {0.f, 0.f, 0.f, 0.f}, y1 = {0.f, 0.f, 0.f, 0.f};
#pragma unroll
        for (int kk = 0; kk < 4; ++kk) {
            y0 = __builtin_amdgcn_mfma_f32_16x16x32_bf16(*(const bf16x8*)(Hb + l15 * S5_HS + (kk * 32 + 8 * l4) * 2), cfr[kk], y0, 0, 0, 0);
            y1 = __builtin_amdgcn_mfma_f32_16x16x32_bf16(*(const bf16x8*)(Hb + (16 + l15) * S5_HS + (kk * 32 + 8 * l4) * 2), cfr[kk], y1, 0, 0, 0);
        }
        const bool fin = c >= (nch >> 1);
#pragma unroll
        for (int mt = 0; mt < 2; ++mt)
#pragma unroll
            for (int r = 0; r < 4; ++r) { const int tau = 32 * c + 16 * mt + 4 * l4 + r, t = d ? L - 1 - tau : tau; const size_t row = (size_t)(row0 + t);
                bf16* sp = SS + row * 512 + g * 16 + l15; float y = mt ? y1[r] : y0[r];
                if (fin) y = gelu_fast(y + bf2f((bf16)pv[4 * mt + r]) + dsk * bf2f((bf16)uv[4 * mt + r]));
                *sp = (bf16)f2bf(y); }
        if (c == (nch >> 1) - 1) __syncthreads();
        if (c + 1 >= (nch >> 1) && c + 1 < nch) {
#pragma unroll
            for (int mt = 0; mt < 2; ++mt)
#pragma unroll
                for (int r = 0; r < 4; ++r) { const int tau = 32 * (c + 1) + 16 * mt + 4 * l4 + r, t = d ? L - 1 - tau : tau; const size_t row = (size_t)(row0 + t);
                    pv[4 * mt + r] = SS[row * 512 + g * 16 + l15]; uv[4 * mt + r] = Z[row * ZP + g * 16 + l15]; }
        }
        asm volatile("" ::: "memory");
    }
    if (!lat && hh == 0) {
#pragma unroll
        for (int q = 0; q < 2; ++q) { float* so = F.out + O_S5 + ((size_t)((((b * 2 + l) * 2 + d) * 32 + g) * 64 + 32 * q + c31)) * 2; so[0] = hr[q]; so[1] = hi[q]; }
    }
    __syncthreads();
}
constexpr int GL_VS = 36, GL_QT = 0, GL_KT = 4608, GL_KTT = 9216, GL_VT = 14336, GL_EB = 24576, GL_BUF = 24832, GL_LR = 2 * GL_BUF, GL_DIR = 2 * GL_BUF + 2 * 8192;
static_assert(GL_DIR <= RING_BYTES, "GLA LDS");
__device__ __forceinline__ void gla_item(const Frame& F, int l, int item) {
    const bool lat = item < 64; const int ii = lat ? item : item - 64, b = ii >> 3, h = (ii >> 1) & 3, d = ii & 1;
    const int L = lat ? L_LAT : L_CTX, row0 = lat ? M_CTX + b * L_LAT : b * L_CTX, nch = L >> 5;
    const bool prod = F.wave >= 4;
    const int sl = F.wave & 3, lane = F.lane, hh = lane >> 5, c31 = lane & 31;
    const bf16* Z = (const bf16*)(F.ws + WS_Z); bf16* GS = (bf16*)(F.ws + WS_GS);
    unsigned char* ldd = F.lds;
    if (prod) {
        const int dka = sl * 16 + (lane & 15), tg = lane >> 4, dt = sl * 64 + lane;
        unsigned wgp[8];
#pragma unroll
        for (int r = 0; r < 8; ++r) wgp[r] = cvtpk(F.in[I_WGK][((size_t)((l * 2 + d) * 16 + 2 * r)) * 256 + h * 64 + dka], F.in[I_WGK][((size_t)((l * 2 + d) * 16 + 2 * r + 1)) * 256 + h * 64 + dka]);
        const float bg = F.in[I_BGK][(l * 2 + d) * 256 + h * 64 + dka];
#define GLA_LR_LOAD(kb, r0_, r1_) do { const int tau = 256 * (kb) + dt, t = d ? L - 1 - tau : tau; const bf16* zr = Z + (size_t)(row0 + t) * ZP + 2816 + d * 16; r0_ = *(const v4u*)zr; r1_ = *(const v4u*)(zr + 8); } while (0)
#define GLA_LR_WRITE(kb, r0_, r1_) do { unsigned char* lp_ = ldd + GL_LR + ((kb) & 1) * 8192 + dt * 32; *(v4u*)lp_ = r0_; *(v4u*)(lp_ + 16) = r1_; } while (0)
#define GLA_IN_LOAD(c, qk_, vv_) do { \
        _Pragma("unroll") for (int e = 0; e < 8; ++e) { const int tau = 32 * (c) + 8 * tg + e, t = d ? L - 1 - tau : tau; const bf16* zr = Z + (size_t)(row0 + t) * ZP; \
            qk_[e] = (unsigned)zr[512 + h * 64 + dka]; qk_[8 + e] = (unsigned)zr[768 + h * 64 + dka]; } \
        _Pragma("unroll") for (int k2 = 0; k2 < 2; ++k2) { const int rho = (lane & 15) + 16 * k2, sg = (lane >> 4) + 4 * sl, tau = 32 * (c) + rho, t = d ? L - 1 - tau : tau; \
            vv_[k2] = *(const v4u*)(Z + (size_t)(row0 + t) * ZP + 1024 + h * 128 + sg * 8); } } while (0)
#define GLA_STEP_A(c, qk_, vv_) do { unsigned char* bufp = ldd + ((c) & 1) * GL_BUF; const unsigned char* lrb = ldd + GL_LR + (((c) >> 3) & 1) * 8192; \
        float gk[8]; \
        _Pragma("unroll") for (int e = 0; e < 8; ++e) { const unsigned char* lrp = lrb + (32 * ((c) & 7) + 8 * tg + e) * 32; const v4u a0 = *(const v4u*)lrp, a1 = *(const v4u*)(lrp + 16); \
            float x = DOT2(a0.x, wgp[0], bg); x = DOT2(a0.y, wgp[1], x); x = DOT2(a0.z, wgp[2], x); x = DOT2(a0.w, wgp[3], x); x = DOT2(a1.x, wgp[4], x); x = DOT2(a1.y, wgp[5], x); x = DOT2(a1.z, wgp[6], x); x = DOT2(a1.w, wgp[7], x); \
            gk[e] = (fminf(x, 0.f) - __logf(1.0f + __expf(-fabsf(x)))) * 0.0625f; } \
        _Pragma("unroll") for (int e = 1; e < 8; ++e) gk[e] += gk[e - 1]; \
        { const float tot = gk[7]; float p1 = __shfl_up(tot, 16), p2 = __shfl_up(tot, 32), p3 = __shfl_up(tot, 48); const float pre = (tg >= 1 ? p1 : 0.f) + (tg >= 2 ? p2 : 0.f) + (tg >= 3 ? p3 : 0.f); \
          _Pragma("unroll") for (int e = 0; e < 8; ++e) gk[e] += pre; } \
        unsigned kt8[4]; \
        _Pragma("unroll") for (int e = 0; e < 8; ++e) { const int rho = 8 * tg + e; const float ep = __expf(gk[e]), em = __builtin_amdgcn_rcpf(ep); const float qv = bflo(qk_[e]) * ep, kv = bflo(qk_[8 + e]) * em; \
            const unsigned pq = cvtpk(qv, kv); ((bf16*)(bufp + GL_QT))[rho * 72 + dka] = (bf16)(pq & 0xffff); ((bf16*)(bufp + GL_KT))[rho * 72 + dka] = (bf16)(pq >> 16); \
            if (e & 1) kt8[e >> 1] |= pq & 0xffff0000u; else kt8[e >> 1] = pq >> 16; } \
        *(v4u*)(bufp + GL_KTT + dka * 80 + tg * 16) = (v4u){kt8[0], kt8[1], kt8[2], kt8[3]}; \
        if (tg == 3) ((float*)(bufp + GL_EB))[dka] = __expf(gk[7]); \
        _Pragma("unroll") for (int k2 = 0; k2 < 2; ++k2) { const int rho = (lane & 15) + 16 * k2, sg = (lane >> 4) + 4 * sl; const v4u vv = vv_[k2]; bf16* vt = (bf16*)(bufp + GL_VT) + (sg * 8) * GL_VS + rho; \
            vt[0] = (bf16)(vv.x & 0xffff); vt[GL_VS] = (bf16)(vv.x >> 16); vt[2 * GL_VS] = (bf16)(vv.y & 0xffff); vt[3 * GL_VS] = (bf16)(vv.y >> 16); vt[4 * GL_VS] = (bf16)(vv.z & 0xffff); vt[5 * GL_VS] = (bf16)(vv.z >> 16); vt[6 * GL_VS] = (bf16)(vv.w & 0xffff); vt[7 * GL_VS] = (bf16)(vv.w >> 16); } \
    } while (0)
        unsigned qk[4][16]; v4u vv2[4][2]; v4u lr0, lr1;
        { int cz = 0; asm volatile("" : "+s"(cz)); GLA_LR_LOAD(cz, lr0, lr1); GLA_LR_WRITE(cz, lr0, lr1);
          GLA_IN_LOAD(cz, qk[0], vv2[0]); GLA_IN_LOAD(cz + 1, qk[1], vv2[1]); GLA_IN_LOAD(cz + 2, qk[2], vv2[2]); GLA_IN_LOAD(cz + 3, qk[3], vv2[3]);
          lds_barrier(); GLA_STEP_A(cz, qk[0], vv2[0]); GLA_IN_LOAD(cz + 4, qk[0], vv2[0]); }
        lds_barrier();
#define GLA_PROD_BLOCK(blk, LAST) do { _Pragma("unroll") for (int u = 0; u < 8; ++u) { const int c = 8 * (blk) + u; \
            if (!(LAST) || u < 7) { \
                if (!(LAST) && u == 4) GLA_LR_LOAD((blk) + 1, lr0, lr1); \
                if (!(LAST) && u == 5) GLA_LR_WRITE((blk) + 1, lr0, lr1); \
                GLA_STEP_A(c + 1, qk[(u + 1) & 3], vv2[(u + 1) & 3]); \
                if (!(LAST) || u < 3) GLA_IN_LOAD(c + 5, qk[(u + 1) & 3], vv2[(u + 1) & 3]); \
                asm volatile("" ::: "memory"); \
            } \
            lds_barrier(); } } while (0)
        const int nblk = nch >> 3;
        for (int b0 = 0; b0 + 1 < nblk; ++b0) { int blk = b0; asm volatile("" : "+s"(blk)); GLA_PROD_BLOCK(blk, false); }
        { int blk = nblk - 1; asm volatile("" : "+s"(blk)); GLA_PROD_BLOCK(blk, true); }
#undef GLA_PROD_BLOCK
#undef GLA_STEP_A
#undef GLA_IN_LOAD
#undef GLA_LR_LOAD
#undef GLA_LR_WRITE
    } else {
        f32x16 S0, S1;
#pragma unroll
        for (int r = 0; r < 16; ++r) {
            const size_t sb = ((size_t)((((b * 2 + l) * 2 + d) * 4 + h) * 64)) * 128 + sl * 32 + c31;
            const float* sp = F.in[I_SGLA] + (lat ? sb : (size_t)0); const float lm = lat ? 1.f : 0.f;
            S0[r] = sp[(size_t)crow(r, hh) * 128] * lm; S1[r] = sp[(size_t)(32 + crow(r, hh)) * 128] * lm; }
        lds_barrier();
        lds_barrier();
        for (int c0 = 0; c0 < nch; ++c0) {
            int c = c0; asm volatile("" : "+s"(c));
            const unsigned char* bufp = ldd + (c & 1) * GL_BUF;
            const bf16* QT = (const bf16*)(bufp + GL_QT); const bf16* KT = (const bf16*)(bufp + GL_KT); const bf16* KTT = (const bf16*)(bufp + GL_KTT); const bf16* VT = (const bf16*)(bufp + GL_VT); const float* EB = (const float*)(bufp + GL_EB);
            f32x16 at = {0.f, 0.f, 0.f, 0.f, 0.f, 0.f, 0.f, 0.f, 0.f, 0.f, 0.f, 0.f, 0.f, 0.f, 0.f, 0.f};
#pragma unroll
            for (int s = 0; s < 4; ++s) at = MFMA32(*(const bf16x8*)(KT + c31 * 72 + 16 * s + 8 * hh), *(const bf16x8*)(QT + c31 * 72 + 16 * s + 8 * hh), at);
#pragma unroll
            for (int r = 0; r < 16; ++r) if (crow(r, hh) > c31) at[r] = 0.f;
            f32x16 o = {0.f, 0.f, 0.f, 0.f, 0.f, 0.f, 0.f, 0.f, 0.f, 0.f, 0.f, 0.f, 0.f, 0.f, 0.f, 0.f};
#pragma unroll
            for (int s = 0; s < 2; ++s) {
                o = MFMA32(cat4(*(const bf16x4*)(QT + c31 * 72 + 16 * s + 4 * hh), *(const bf16x4*)(QT + c31 * 72 + 16 * s + 8 + 4 * hh)), acc_frag(S0, s), o);
                o = MFMA32(cat4(*(const bf16x4*)(QT + c31 * 72 + 32 + 16 * s + 4 * hh), *(const bf16x4*)(QT + c31 * 72 + 32 + 16 * s + 8 + 4 * hh)), acc_frag(S1, s), o);
            }
            const bf16* vtr = VT + (sl * 32 + c31) * GL_VS;
#pragma unroll
            for (int s = 0; s < 2; ++s) o = MFMA32(acc_frag(at, s), cat4(*(const bf16x4*)(vtr + 16 * s + 4 * hh), *(const bf16x4*)(vtr + 16 * s + 8 + 4 * hh)), o);
#pragma unroll
            for (int r = 0; r < 16; r += 2) { const unsigned po = cvtpk(o[r], o[r + 1]); const int tau = 32 * c + crow(r, hh), t = d ? L - 1 - tau : tau, t1 = d ? t - 1 : t + 1;
                bf16* gp = GS + (size_t)d * M_TOK * 512 + h * 128 + sl * 32 + c31; gp[(size_t)(row0 + t) * 512] = (bf16)(po & 0xffff); gp[(size_t)(row0 + t1) * 512] = (bf16)(po >> 16); }
#pragma unroll
            for (int s = 0; s < 2; ++s) { const bf16x8 vb = cat4(*(const bf16x4*)(vtr + 16 * s + 8 * hh), *(const bf16x4*)(vtr + 16 * s + 8 * hh + 4));
                S0 = MFMA32(*(const bf16x8*)(KTT + c31 * 40 + 16 * s + 8 * hh), vb, S0); S1 = MFMA32(*(const bf16x8*)(KTT + (32 + c31) * 40 + 16 * s + 8 * hh), vb, S1); }
#pragma unroll
            for (int g4 = 0; g4 < 4; ++g4) { const f32x4 e0 = *(const f32x4*)(EB + 8 * g4 + 4 * hh), e1 = *(const f32x4*)(EB + 32 + 8 * g4 + 4 * hh);
#pragma unroll
                for (int i = 0; i < 4; ++i) { S0[4 * g4 + i] *= e0[i]; S1[4 * g4 + i] *= e1[i]; } }
            lds_barrier();
        }
        if (!lat) {
#pragma unroll
            for (int r = 0; r < 16; ++r) { float* so = F.out + O_GLA + ((size_t)((((b * 2 + l) * 2 + d) * 4 + h) * 64)) * 128 + sl * 32 + c31;
                so[(size_t)crow(r, hh) * 128] = S0[r]; so[(size_t)(32 + crow(r, hh)) * 128] = S1[r]; }
        }
    }
    __syncthreads();
}
__device__ __forceinline__ void gla_combine_rows(const Frame& F, int l) {
    const bf16* Z = (const bf16*)(F.ws + WS_Z); const bf16* GS = (const bf16*)(F.ws + WS_GS); bf16* YB = (bf16*)(F.ws + WS_Y);
    const int gw = F.bid * NWAVES + F.wave, NGW = F.G * NWAVES;
    const float* gn = F.in[I_GNG] + l * 128 + 2 * F.lane; const float gn0 = gn[0], gn1 = gn[1];
    for (int u0 = gw * 4; u0 < M_TOK * 4; u0 += NGW * 4) {
        unsigned a[4], bb[4], gg[4];
#pragma unroll
        for (int k = 0; k < 4; ++k) { const int u = u0 + k; const size_t row = (size_t)(u >> 2); const int c = (u & 3) * 128 + 2 * F.lane;
            a[k] = *(const unsigned*)(GS + row * 512 + c); bb[k] = *(const unsigned*)(GS + (size_t)M_TOK * 512 + row * 512 + c); gg[k] = *(const unsigned*)(Z + row * ZP + 1536 + c); }
#pragma unroll
        for (int k = 0; k < 4; ++k) { const int u = u0 + k; const size_t row = (size_t)(u >> 2); const int c = (u & 3) * 128 + 2 * F.lane;
            const float o0 = bflo(a[k]) + bflo(bb[k]), o1 = bfhi(a[k]) + bfhi(bb[k]);
            const float rstd = 1.0f / sqrtf(wave_sum(o0 * o0 + o1 * o1) * (1.0f / 128.0f) + RMS_EPS);
            const float g0 = bflo(gg[k]), g1 = bfhi(gg[k]);
            *(unsigned*)(YB + row * 512 + c) = pk2(o0 * rstd * gn0 * (g0 / (1.0f + __expf(-g0))), o1 * rstd * gn1 * (g1 / (1.0f + __expf(-g1)))); }
    }
}
constexpr int AT_K = 0, AT_VT = 4608, AT_BUF = 9728;
__device__ __forceinline__ void attn_item(const Frame& F, int l, int item) {
    const bool lat = item < 256; const int ii = lat ? item : item - 256;
    const int b = lat ? ii >> 5 : ii >> 3, kvh = lat ? (ii >> 4) & 1 : (ii >> 2) & 1, qt = lat ? ii & 15 : ii & 3;
    const int L = lat ? L_LAT : L_CTX, row0 = lat ? M_CTX + b * L_LAT : b * L_CTX, q0 = qt * 64;
    const int w = F.wave, lane = F.lane, hh = lane >> 5, c31 = lane & 31, hq = kvh * 4 + (w >> 1), tq = q0 + 32 * (w & 1) + c31;
    const bf16* Z = (const bf16*)(F.ws + WS_Z); bf16* YC = (bf16*)(F.ws + WS_Y) + (size_t)M_TOK * 512;
    const bf16* ck = (const bf16*)(F.ws + WS_CKV) + (size_t)((l * 8 + b) * 256) * 128 + kvh * 64; const bf16* cv = ck + 524288;
    const int j0 = lat ? (q0 - 128 < 0 ? 0 : q0 - 128) : 0, j1 = lat ? (q0 + 192 > L ? L : q0 + 192) : L;
    const int nw = (j1 - j0) >> 5, nt = lat ? nw + 8 : nw;
    bf16x8 qf[4];
    { const bf16* qp = Z + (size_t)(row0 + tq) * ZP + 2048 + hq * 64 + 8 * hh;
#pragma unroll
      for (int s = 0; s < 4; ++s) qf[s] = *(const bf16x8*)(qp + 16 * s); }
    f32x16 O0 = {0.f, 0.f, 0.f, 0.f, 0.f, 0.f, 0.f, 0.f, 0.f, 0.f, 0.f, 0.f, 0.f, 0.f, 0.f, 0.f}, O1 = O0;
    float m = F.in[I_SINK][l * 8 + hq], ls = 1.0f;
    const int st = (w & 3) * 64 + lane, skey = (st & 15) + 16 * ((st >> 4) & 1), sseg = st >> 5; const bool isk = w < 4;
#define AT_SRC(kt) ((kt) < nw ? Z + (size_t)(row0 + j0 + 32 * (kt) + skey) * ZP + (isk ? 2560 : 2688) + kvh * 64 + sseg * 8 : (isk ? ck : cv) + (size_t)(32 * ((kt) - nw) + skey) * 128 + sseg * 8)
#define AT_WRITE(kt, val) do { unsigned char* bp = F.lds + ((kt) & 1) * AT_BUF; \
        if (isk) *(v4u*)(bp + AT_K + skey * 144 + sseg * 16) = (val); \
        else { bf16* vt = (bf16*)(bp + AT_VT) + (sseg * 8) * 36 + skey; vt[0] = (bf16)((val).x & 0xffff); vt[36] = (bf16)((val).x >> 16); vt[72] = (bf16)((val).y & 0xffff); vt[108] = (bf16)((val).y >> 16); \
               vt[144] = (bf16)((val).z & 0xffff); vt[180] = (bf16)((val).z >> 16); vt[216] = (bf16)((val).w & 0xffff); vt[252] = (bf16)((val).w >> 16); } } while (0)
    { const v4u v0 = *(const v4u*)AT_SRC(0); AT_WRITE(0, v0); }
    __syncthreads();
    for (int kt0 = 0; kt0 < nt; ++kt0) {
        int kt = kt0; asm volatile("" : "+s"(kt));
        v4u pre = {0u, 0u, 0u, 0u}; if (kt + 1 < nt) pre = *(const v4u*)AT_SRC(kt + 1);
        asm volatile("" ::: "memory");
        const unsigned char* bp = F.lds + (kt & 1) * AT_BUF; const bf16* KT = (const bf16*)(bp + AT_K); const bf16* VT = (const bf16*)(bp + AT_VT);
        f32x16 sc = {0.f, 0.f, 0.f, 0.f, 0.f, 0.f, 0.f, 0.f, 0.f, 0.f, 0.f, 0.f, 0.f, 0.f, 0.f, 0.f};
#pragma unroll
        for (int s = 0; s < 4; ++s) sc = MFMA32(*(const bf16x8*)(KT + c31 * 72 + 16 * s + 8 * hh), qf[s], sc);
        if (lat && kt < nw) { const int jb = j0 + 32 * kt - tq;
#pragma unroll
            for (int r = 0; r < 16; ++r) { const int dj = jb + crow(r, hh); if (dj > 128 || dj < -128) sc[r] = -INFINITY; } }
        float mx = sc[0];
#pragma unroll
        for (int r = 1; r < 16; ++r) mx = fmaxf(mx, sc[r]);
        mx = fmaxf(mx, __shfl_xor(mx, 32));
        const float mn = fmaxf(m, mx), al = __expf(m - mn); m = mn;
        float ps = 0.f;
#pragma unroll
        for (int r = 0; r < 16; ++r) { sc[r] = __expf(sc[r] - mn); ps += sc[r]; }
        ps += __shfl_xor(ps, 32); ls = ls * al + ps;
#pragma unroll
        for (int r = 0; r < 16; ++r) { O0[r] *= al; O1[r] *= al; }
#pragma unroll
        for (int s = 0; s < 2; ++s) { const bf16x8 pf = acc_frag(sc, s);
            O0 = MFMA32(cat4(*(const bf16x4*)(VT + c31 * 36 + 16 * s + 4 * hh), *(const bf16x4*)(VT + c31 * 36 + 16 * s + 8 + 4 * hh)), pf, O0);
            O1 = MFMA32(cat4(*(const bf16x4*)(VT + (32 + c31) * 36 + 16 * s + 4 * hh), *(const bf16x4*)(VT + (32 + c31) * 36 + 16 * s + 8 + 4 * hh)), pf, O1); }
        if (kt + 1 < nt) AT_WRITE(kt + 1, pre);
        lds_barrier();
    }
#undef AT_SRC
#undef AT_WRITE
    const float inv = 1.0f / ls;
    bf16* op = YC + (size_t)(row0 + tq) * 512 + hq * 64 + 4 * hh;
#pragma unroll
    for (int g = 0; g < 4; ++g) {
        v2u w0; w0.x = cvtpk(O0[4 * g] * inv, O0[4 * g + 1] * inv); w0.y = cvtpk(O0[4 * g + 2] * inv, O0[4 * g + 3] * inv); *(v2u*)(op + 8 * g) = w0;
        v2u w1; w1.x = cvtpk(O1[4 * g] * inv, O1[4 * g + 1] * inv); w1.y = cvtpk(O1[4 * g + 2] * inv, O1[4 * g + 3] * inv); *(v2u*)(op + 32 + 8 * g) = w1; }
}
__device__ __forceinline__ void mixer_phase(const Frame& F, int l) {
    unsigned* qhead = (unsigned*)(F.ws + WS_CTL) + 64 * (1 + l);
    volatile unsigned* slot = (volatile unsigned*)(F.lds + MISC_OFF) + 12;
    for (;;) {
        if (F.tid == 0) *slot = __hip_atomic_fetch_add(qhead, 1u, __ATOMIC_RELAXED, __HIP_MEMORY_SCOPE_AGENT);
        __syncthreads();
        int it = __builtin_amdgcn_readfirstlane((int)*slot);
        if (it >= 768) break;
        int kind, idx;
        if (it < 64) { kind = 1; idx = it; } else if (it < 128) { kind = 0; idx = it - 64; } else if (it < 384) { kind = 2; idx = it - 128; }
        else if (it < 512) { kind = 1; idx = it - 384 + 64; } else if (it < 640) { kind = 0; idx = it - 512 + 64; } else { kind = 2; idx = it - 640 + 256; }
        Frame G = F;
        { int tid = F.tid; asm volatile("" : "+v"(tid)); asm volatile("" : "+s"(idx)); G.tid = tid; G.lane = tid & 63; G.wave = __builtin_amdgcn_readfirstlane(tid >> 6); }
        if (kind == 0) s5_item(G, l, idx);
        else if (kind == 1) gla_item(G, l, idx);
        else attn_item(G, l, idx);
    }
    __syncthreads();
}

constexpr int N_PHASES = 20;
__global__ void __launch_bounds__(NWAVES * 64, 2) fwd_kernel(Args args) {
    extern __shared__ __attribute__((aligned(16))) unsigned char lds[];
    Frame F;
    F.lds = lds; F.tid = threadIdx.x; F.lane = F.tid & 63; F.wave = __builtin_amdgcn_readfirstlane(F.tid >> 6); F.G = gridDim.x; F.bid = blockIdx.x;
    F.in = (kargs_t)__builtin_amdgcn_kernarg_segment_ptr();
    F.out = (float*)F.in[N_IN]; F.ws = (unsigned char*)F.in[N_IN + 1];
    LAS unsigned char* llds = (LAS unsigned char*)lds;
    for (int u = F.tid; u < (LDS_BYTES - LDSCTL_OFF) / 4; u += NWAVES * 64) ((LAS unsigned*)(llds + LDSCTL_OFF))[u] = 0u;
    __syncthreads();
    XcdBarrier bar; bar.bar = (unsigned*)(F.ws + WS_CTL) + CW_BAR; bar.x = 0; bar.st = nullptr;
    const int ph_lo = args.ph_lo, ph_hi = args.ph_hi;
    if (ph_hi - ph_lo > 1) bar = xcd_barrier_post((unsigned*)(F.ws + WS_CTL) + CW_BAR, (volatile LAS unsigned*)(llds + MISC_OFF) + 8);
    for (int ph = ph_lo; ph < ph_hi; ++ph) {
        { kargs_t kp = (kargs_t)__builtin_amdgcn_kernarg_segment_ptr(); asm volatile("" : "+s"(kp)); F.in = kp; F.out = (float*)kp[N_IN]; F.ws = (unsigned char*)kp[N_IN + 1]; }
        { int tid = threadIdx.x; asm volatile("" : "+v"(tid)); int bid = blockIdx.x; asm volatile("" : "+s"(bid));
          F.tid = tid; F.lane = tid & 63; F.wave = __builtin_amdgcn_readfirstlane(tid >> 6); F.bid = bid; }
        unsigned char* ws = F.ws;
        bf16* WT = (bf16*)(ws + WS_W);
        if (ph == 0) p0_prologue(F);
        else if (ph == 1) norm_phase(F, 0, 0);
        else {
            const int l = (ph - 2) / 9, s = (ph - 2) % 9;
            if (s == 0) {
                pg8::Gemm g{(const bf16*)(ws + WS_XN), WT + WO_IN, M_TOK, NZ, 1024, nullptr, nullptr}; pg8::StaticOrder S; S.init(M_TOK, NZ, F.G, F.bid);
                pg8::EpiWin E{(bf16*)(ws + WS_Z), (bf16*)(ws + WS_G), F.out + O_CK + l * 32768, F.out + O_CV + l * 32768, (const float*)(ws + WS_ROPE)};
                pg8::gemm_phase<pg8::EpiWin, pg8::StaticOrder, true>(llds + RING_OFF, g, S, E, F.tid);
            } else if (s == 1) {
                mixer_phase(F, l);
            } else if (s == 2) {
                gla_combine_rows(F, l);
                pg8::Gemm g{(const bf16*)(ws + WS_XN), WT + WO_GLU, M_TOK, 1024, 512, nullptr, nullptr}; pg8::StaticOrder S; S.init(M_TOK, 1024, F.G, F.bid);
                pg8::EpiGlu<0> E{(bf16*)(ws + WS_XN) + (size_t)M_TOK * 512, 512};
                pg8::gemm_phase<pg8::EpiGlu<0>, pg8::StaticOrder, true>(llds + RING_OFF, g, S, E, F.tid);
            } else if (s == 3) {
                pg8::Gemm g{(const bf16*)(ws + WS_XN) + (size_t)M_TOK * 512, WT + WO_BR, M_TOK, 1024, 512, (const bf16*)(ws + WS_Y), (const bf16*)(ws + WS_Y) + (size_t)M_TOK * 512};
                pg8::BranchOrder S; S.init(M_TOK, 1024, F.G, F.bid);
                pg8::EpiBranch E{(const bf16*)(ws + WS_G), (float*)(ws + WS_Z), (bf16*)(ws + WS_GS)};
                pg8::gemm_phase<pg8::EpiBranch, pg8::BranchOrder, true>(llds + RING_OFF, g, S, E, F.tid);
            } else if (s == 4) {
                pg8::Gemm g{(const bf16*)(ws + WS_GS), WT + WO_OUT, M_TOK, 1024, 1024, nullptr, nullptr}; pg8::StaticOrder S; S.init(M_TOK, 1024, F.G, F.bid);
                pg8::EpiF32 E{(float*)(ws + WS_Z), 1024};
                pg8::gemm_phase<pg8::EpiF32, pg8::StaticOrder, true>(llds + RING_OFF, g, S, E, F.tid);
            } else if (s == 5) {
                norm_phase(F, l, 1);
            } else if (s == 6) {
                pg8::Gemm g{(const bf16*)(ws + WS_XN), WT + WO_W1, M_TOK, FF2, 1024, nullptr, nullptr}; pg8::StaticOrder S; S.init(M_TOK, FF2, F.G, F.bid);
                pg8::EpiGlu<1> E{(bf16*)(ws + WS_G), FFH};
                pg8::gemm_phase<pg8::EpiGlu<1>, pg8::StaticOrder, true>(llds + RING_OFF, g, S, E, F.tid);
            } else if (s == 7) {
                pg8::Gemm g{(const bf16*)(ws + WS_G), WT + WO_W2, M_TOK, 1024, FFH, nullptr, nullptr}; pg8::StaticOrder S; S.init(M_TOK, 1024, F.G, F.bid);
                pg8::EpiF32 E{(float*)(ws + WS_Z), 1024};
                pg8::gemm_phase<pg8::EpiF32, pg8::StaticOrder, true>(llds + RING_OFF, g, S, E, F.tid);
            } else {
                norm_phase(F, l, 2);
                if (l == 0) convert_weights(F, 1);
            }
        }
        if (ph + 1 < ph_hi) xcd_barrier(bar);
    }
}

extern "C" void kernel_launch(void* const* d_in, const int* in_sizes, int n_in, void* d_out, int out_size, void* d_ws, size_t ws_size, hipStream_t stream) {
    static int grid = 0;
    if (grid == 0) {
        if (n_in != N_IN || out_size != (int)O_END || ws_size < WS_END) fprintf(stderr, "kernel_launch: unexpected shapes: n_in %d out %d ws %zu\n", n_in, out_size, ws_size);
        int dev = 0, cus = 0, per_cu = 0;
        if (hipGetDevice(&dev) != hipSuccess || hipDeviceGetAttribute(&cus, hipDeviceAttributeMultiprocessorCount, dev) != hipSuccess || cus <= 0) cus = 256;
        if (hipFuncSetAttribute((const void*)fwd_kernel, hipFuncAttributeMaxDynamicSharedMemorySize, LDS_BYTES) != hipSuccess) fprintf(stderr, "kernel_launch: hipFuncSetAttribute failed\n");
        if (hipOccupancyMaxActiveBlocksPerMultiprocessor(&per_cu, (const void*)fwd_kernel, NWAVES * 64, LDS_BYTES) != hipSuccess || per_cu < 1) fprintf(stderr, "kernel_launch: occupancy query reports %d workgroups per CU\n", per_cu);
        (void)hipGetLastError();
        grid = cus;
    }
    (void)hipMemsetAsync((char*)d_ws + WS_CTL, 0, CTL_ZERO_BYTES, stream);
    Args a{};
    for (int i = 0; i < N_IN; ++i) a.in[i] = (const float*)d_in[i];
    a.out = (float*)d_out; a.ws = (unsigned char*)d_ws;
#if MK_PER_PHASE
    for (int ph = 0; ph < N_PHASES; ++ph) { a.ph_lo = ph; a.ph_hi = ph + 1; hipLaunchKernelGGL(fwd_kernel, dim3(grid), dim3(NWAVES * 64), LDS_BYTES, stream, a); }
#else
    a.ph_lo = 0; a.ph_hi = N_PHASES;
    hipLaunchKernelGGL(fwd_kernel, dim3(grid), dim3(NWAVES * 64), LDS_BYTES, stream, a);
#endif
}
```
